# Optimizing an MI355X kernel written in HIP

```python
import math
import jax, jax.numpy as jnp
from jax import lax
import numpy as np

D_MODEL = 2048
BATCH = 2
SEQ = 8192
DEPTH = 2

N_META = 16
CHUNK = 128
N_BRANCH = 4
BRANCH_W = D_MODEL // 4
EPS = 1e-6
LRU_BLOCKS = 8
LRU_BLOCK_DIM = BRANCH_W // LRU_BLOCKS
LRU_CONV = 4
LRU_PAD = (2, 1)
LRU_C = 8.0
HY_CONV = 3
HY_PAD = (1, 1)
HY_BANDS = 16
HY_EMB = 1 + 2 * HY_BANDS
HY_FFN = 64
HY_SIN_FREQ = 1.0
HY_DECAY_MIN = 3.07
HY_DECAY_MAX = 15.35
HY_FILTER_SCALE = 0.004
RET_HEADS = 4
RET_DK = BRANCH_W // RET_HEADS
RET_DV = BRANCH_W // RET_HEADS
ROPE_BASE = 10000.0
HG_HEADS = 4
HG_EXPAND = BRANCH_W // HG_HEADS
D_FF = -(-8 * D_MODEL // (3 * 256)) * 256
GATE_COLS = N_BRANCH * D_MODEL
MIX_COLS = 14 * BRANCH_W
N_IN_COLS = MIX_COLS + GATE_COLS
F32 = jnp.float32

kernel_name = "hybrid_rglru_hyena_retention_hgrn2_encoder"


def rms_norm(x, gain):
    xf = x.astype(F32)
    y = xf * lax.rsqrt(jnp.mean(xf * xf, axis=-1, keepdims=True) + EPS)
    return (y * gain.astype(F32)).astype(x.dtype)


def depthwise_conv(x, w, b, pad):
    y = lax.conv_general_dilated(x, w[:, None, :].astype(x.dtype), window_strides=(1,), padding=[pad],
                                 dimension_numbers=('NWC', 'WIO', 'NWC'), feature_group_count=x.shape[-1])
    return y + b.astype(x.dtype)


def split_projection(p):
    w = BRANCH_W
    sizes = (w, w, 3 * w, w, w, w, w, w, w, w, w, w, GATE_COLS)
    out, start = [], 0
    for s in sizes:
        out.append(p[..., start:start + s])
        start += s
    return out


def rglru_direction(xc, wa, ba, wx, bx, lam, reverse):
    bsz, t_len, width = xc.shape
    xb = xc.reshape(bsz, t_len, LRU_BLOCKS, LRU_BLOCK_DIM)
    gate_r = jax.nn.sigmoid(jnp.einsum('btki,kij->btkj', xb, wa).reshape(bsz, t_len, width).astype(F32) + ba.astype(F32))
    gate_i = jax.nn.sigmoid(jnp.einsum('btki,kij->btkj', xb, wx).reshape(bsz, t_len, width).astype(F32) + bx.astype(F32))
    log_a = -LRU_C * gate_r * jax.nn.softplus(-lam.astype(F32))
    a = jnp.exp(log_a)
    b = jnp.sqrt(-jnp.expm1(2.0 * log_a)) * gate_i * xc.astype(F32)

    def combine(left, right):
        a1, b1 = left
        a2, b2 = right
        return a1 * a2, a2 * b1 + b2

    _, h = lax.associative_scan(combine, (a, b), axis=1, reverse=reverse)
    return h


def rglru_branch(xa, ga, conv_w, conv_b, wa, ba, wx, bx, lam):
    xc = depthwise_conv(xa, conv_w, conv_b, LRU_PAD)
    h = (rglru_direction(xc, wa[0], ba[0], wx[0], bx[0], lam[0], False)
         + rglru_direction(xc, wa[1], ba[1], wx[1], bx[1], lam[1], True))
    return (h * jax.nn.gelu(ga.astype(F32))).astype(xa.dtype)


def hyena_filters(t_len, w1, b1, w2, b2, w3, decay):
    n = jnp.arange(t_len, dtype=F32)
    t = n / max(t_len - 1, 1)
    freqs = jnp.linspace(1e-4, HY_BANDS - 1, HY_BANDS, dtype=F32)
    ang = 2.0 * math.pi * n[:, None] * freqs[None, :] / t_len
    z = jnp.concatenate([t[:, None], jnp.cos(ang), -jnp.sin(ang)], axis=-1)
    h = jnp.sin(HY_SIN_FREQ * (z @ w1.astype(F32) + b1.astype(F32)))
    h = jnp.sin(HY_SIN_FREQ * (h @ w2.astype(F32) + b2.astype(F32)))
    h = h @ w3.astype(F32)
    return h * jnp.exp(-t[:, None] * jnp.abs(decay.astype(F32))[None, :])


def hyena_branch(u3, conv_w, conv_b, w1, b1, w2, b2, w3, decay, bias):
    u3 = depthwise_conv(u3, conv_w, conv_b, HY_PAD)
    x0, x1, v = jnp.split(u3, 3, axis=-1)
    t_len = u3.shape[1]
    filt = hyena_filters(t_len, w1, b1, w2, b2, w3, decay)
    h_fwd, h_bwd = filt[:, :BRANCH_W], filt[:, BRANCH_W:]
    k2 = jnp.concatenate([h_fwd, jnp.zeros((1, BRANCH_W), F32), h_bwd[:0:-1]], axis=0)
    u = (x1 * v).astype(F32)
    n_fft = 2 * t_len
    y = jnp.fft.irfft(jnp.fft.rfft(u, n=n_fft, axis=1) * jnp.fft.rfft(k2, n=n_fft, axis=0)[None],
                      n=n_fft, axis=1)[:, :t_len]
    y = y + u * bias.astype(F32)
    return (x0.astype(F32) * y).astype(u3.dtype)


def to_heads(x, n_heads):
    bsz, t_len, _ = x.shape
    return x.reshape(bsz, t_len, n_heads, -1).transpose(0, 2, 1, 3)


def from_heads(x):
    bsz, n_heads, t_len, d = x.shape
    return x.transpose(0, 2, 1, 3).reshape(bsz, t_len, n_heads * d)


def rotary(x):
    t_len, d = x.shape[2], x.shape[3]
    inv = ROPE_BASE ** (-jnp.arange(0, d, 2, dtype=F32) / d)
    ang = jnp.arange(t_len, dtype=F32)[:, None] * inv[None, :]
    cos, sin = jnp.cos(ang), jnp.sin(ang)
    xa, xb = x[..., : d // 2], x[..., d // 2:]
    return jnp.concatenate([xa * cos - xb * sin, xb * cos + xa * sin], axis=-1)


def gla_chunk_scan(q, k, v, log_f, inclusive):
    bsz, n_heads, t_len, dk = q.shape
    dv = v.shape[-1]
    n_chunks = t_len // CHUNK

    def chunks(a):
        return a.reshape(bsz, n_heads, n_chunks, CHUNK, a.shape[-1]).transpose(2, 0, 1, 3, 4)

    qc, kc, vc = chunks(q), chunks(k), chunks(v)
    bc = jnp.cumsum(chunks(log_f), axis=-2)
    idx = jnp.arange(CHUNK)
    mask = (idx[:, None] >= idx[None, :]) if inclusive else (idx[:, None] > idx[None, :])

    def step(state, inp):
        q_, k_, v_, b_ = inp
        diff = b_[..., :, None, :] - b_[..., None, :, :]
        dec = jnp.exp(jnp.where(mask[:, :, None], diff, -jnp.inf))
        scores = jnp.einsum('bhid,bhjd,bhijd->bhij', q_, k_, dec)
        out = (jnp.einsum('bhij,bhjv->bhiv', scores, v_)
               + jnp.einsum('bhid,bhdv->bhiv', q_ * jnp.exp(b_), state))
        b_last = b_[..., -1:, :]
        state = (jnp.exp(b_last[..., 0, :])[..., None] * state
                 + jnp.einsum('bhjd,bhjv->bhdv', k_ * jnp.exp(b_last - b_), v_))
        return state, out

    s0 = jnp.zeros((bsz, n_heads, dk, dv), F32)
    _, o = lax.scan(step, s0, (qc, kc, vc, bc))
    return o.transpose(1, 2, 0, 3, 4).reshape(bsz, n_heads, t_len, dv)


def bidirectional_gla(q, k_fwd, k_bwd, v, logf_fwd, logf_bwd, inclusive_bwd):
    pad = CHUNK - N_META

    def padf(a):
        return jnp.pad(a, ((0, 0), (0, 0), (pad, 0), (0, 0)))

    def flipf(a):
        return jnp.flip(padf(a), axis=2)

    fwd = gla_chunk_scan(padf(q), padf(k_fwd), padf(v), padf(logf_fwd), True)
    bwd = jnp.flip(gla_chunk_scan(flipf(q), flipf(k_bwd), flipf(v), flipf(logf_bwd), inclusive_bwd), axis=2)
    return (fwd + bwd)[:, :, pad:]


def retention_branch(q, k, v, g):
    qh = rotary(to_heads(q.astype(F32), RET_HEADS))
    kh = rotary(to_heads(k.astype(F32), RET_HEADS)) * (RET_DK ** -0.5)
    vh = to_heads(v.astype(F32), RET_HEADS)
    log_gamma = jnp.log1p(-(2.0 ** (-5.0 - jnp.arange(RET_HEADS, dtype=F32))))
    logf = jnp.broadcast_to(log_gamma[None, :, None, None], qh.shape)
    o = bidirectional_gla(qh, kh, kh, vh, logf, logf, inclusive_bwd=False)
    mu = jnp.mean(o, axis=-1, keepdims=True)
    o = (o - mu) * lax.rsqrt(jnp.mean((o - mu) ** 2, axis=-1, keepdims=True) + EPS)
    return (from_heads(o) * jax.nn.silu(g.astype(F32))).astype(q.dtype)


def hgrn_lower_bound(lb_logits, layer):
    c = jnp.cumsum(jax.nn.softmax(lb_logits.astype(F32), axis=0), axis=0)
    return c[layer] - c[0]


def hgrn2_branch(q, f_fwd, f_bwd, i, g, lb):
    qh = to_heads(jax.nn.silu(q.astype(F32)), HG_HEADS)
    ff = lb + (1.0 - lb) * jax.nn.sigmoid(f_fwd.astype(F32))
    fb = lb + (1.0 - lb) * jax.nn.sigmoid(f_bwd.astype(F32))
    o = bidirectional_gla(qh, to_heads(1.0 - ff, HG_HEADS), to_heads(1.0 - fb, HG_HEADS),
                          to_heads(i.astype(F32), HG_HEADS),
                          to_heads(jnp.log(ff), HG_HEADS), to_heads(jnp.log(fb), HG_HEADS), inclusive_bwd=True)
    o = o * lax.rsqrt(jnp.mean(o * o, axis=-1, keepdims=True) + EPS)
    return (from_heads(o) * jax.nn.silu(g.astype(F32))).astype(q.dtype)


def mixer_block(n, w_in, lru_conv_w, lru_conv_b, lru_wa, lru_ba, lru_wx, lru_bx, lru_lambda,
                hy_conv_w, hy_conv_b, hy_w1, hy_b1, hy_w2, hy_b2, hy_w3, hy_decay, hy_bias,
                lb, w_branch_out, w_out):
    bsz, t_len, _ = n.shape
    p = n @ w_in
    (a_x, a_g, b_u, c_q, c_k, c_v, c_g, d_q, d_ff, d_fb, d_i, d_g, gate_cols) = split_projection(p)
    za = rglru_branch(a_x, a_g, lru_conv_w, lru_conv_b, lru_wa, lru_ba, lru_wx, lru_bx, lru_lambda)
    zb = hyena_branch(b_u, hy_conv_w, hy_conv_b, hy_w1, hy_b1, hy_w2, hy_b2, hy_w3, hy_decay, hy_bias)
    zc = retention_branch(c_q, c_k, c_v, c_g)
    zd = hgrn2_branch(d_q, d_ff, d_fb, d_i, d_g, lb)
    z = jnp.stack([za, zb, zc, zd], axis=2)
    up = jnp.einsum('btnw,nwd->btnd', z, w_branch_out)
    gates = jax.nn.sigmoid(gate_cols.reshape(bsz, t_len, N_BRANCH, D_MODEL).astype(F32))
    merged = jnp.sum(gates * up.astype(F32), axis=2).astype(n.dtype)
    return merged @ w_out


def swiglu(n, w_gate, w_up, w_down):
    return (jax.nn.silu(n @ w_gate) * (n @ w_up)) @ w_down


def setup_inputs(seed: int = 0) -> dict:
    key = jax.random.key(seed)
    ks = jax.random.split(key, 28)
    L, W = DEPTH, BRANCH_W

    def normal(k, shape, scale):
        return jax.random.normal(k, shape, F32) * scale

    u_lam = jax.random.uniform(ks[11], (L, 2, W), F32, minval=0.9, maxval=0.999)
    a_lam = u_lam ** (1.0 / LRU_C)
    decay0 = jnp.tile(jnp.linspace(HY_DECAY_MIN, HY_DECAY_MAX, W, dtype=F32), 2)
    return {
        'x': normal(ks[0], (BATCH, SEQ, D_MODEL), 1.0),
        'meta': normal(ks[1], (N_META, D_MODEL), 1.0),
        'norm_mix': 1.0 + normal(ks[2], (L, D_MODEL), 0.02),
        'norm_ffn': 1.0 + normal(ks[3], (L, D_MODEL), 0.02),
        'w_in': normal(ks[4], (L, D_MODEL, N_IN_COLS), D_MODEL ** -0.5),
        'lru_conv_w': normal(ks[5], (L, LRU_CONV, W), LRU_CONV ** -0.5),
        'lru_conv_b': normal(ks[6], (L, W), 0.02),
        'lru_wa': normal(ks[7], (L, 2, LRU_BLOCKS, LRU_BLOCK_DIM, LRU_BLOCK_DIM), LRU_BLOCK_DIM ** -0.5),
        'lru_ba': normal(ks[8], (L, 2, W), 0.02),
        'lru_wx': normal(ks[9], (L, 2, LRU_BLOCKS, LRU_BLOCK_DIM, LRU_BLOCK_DIM), LRU_BLOCK_DIM ** -0.5),
        'lru_bx': normal(ks[10], (L, 2, W), 0.02),
        'lru_lambda': jnp.log(a_lam) - jnp.log1p(-a_lam),
        'hy_conv_w': normal(ks[12], (L, HY_CONV, 3 * W), HY_CONV ** -0.5),
        'hy_conv_b': normal(ks[13], (L, 3 * W), 0.02),
        'hy_w1': normal(ks[14], (L, HY_EMB, HY_FFN), HY_EMB ** -0.5),
        'hy_b1': normal(ks[15], (L, HY_FFN), 0.1),
        'hy_w2': normal(ks[16], (L, HY_FFN, HY_FFN), HY_FFN ** -0.5),
        'hy_b2': normal(ks[17], (L, HY_FFN), 0.1),
        'hy_w3': normal(ks[18], (L, HY_FFN, 2 * W), HY_FILTER_SCALE),
        'hy_decay': decay0[None, :] + normal(ks[19], (L, 2 * W), 0.1),
        'hy_bias': normal(ks[20], (L, W), 0.5),
        'hgrn_lb_logits': normal(ks[21], (L, W), 0.1),
        'w_branch_out': normal(ks[22], (L, N_BRANCH, W, D_MODEL), W ** -0.5),
        'w_out': normal(ks[23], (L, D_MODEL, D_MODEL), D_MODEL ** -0.5),
        'ffn_w_gate': normal(ks[24], (L, D_MODEL, D_FF), D_MODEL ** -0.5),
        'ffn_w_up': normal(ks[25], (L, D_MODEL, D_FF), D_MODEL ** -0.5),
        'ffn_w_down': normal(ks[26], (L, D_FF, D_MODEL), D_FF ** -0.5),
        'norm_final': 1.0 + normal(ks[27], (D_MODEL,), 0.02),
    }


def reference(x, meta, norm_mix, norm_ffn, w_in, lru_conv_w, lru_conv_b, lru_wa, lru_ba, lru_wx, lru_bx,
              lru_lambda, hy_conv_w, hy_conv_b, hy_w1, hy_b1, hy_w2, hy_b2, hy_w3, hy_decay, hy_bias,
              hgrn_lb_logits, w_branch_out, w_out, ffn_w_gate, ffn_w_up, ffn_w_down, norm_final):
    bsz = x.shape[0]
    h = jnp.concatenate([jnp.broadcast_to(meta[None].astype(x.dtype), (bsz, N_META, D_MODEL)), x], axis=1)
    for l in range(DEPTH):
        lb = hgrn_lower_bound(hgrn_lb_logits, l)
        h = h + mixer_block(rms_norm(h, norm_mix[l]), w_in[l], lru_conv_w[l], lru_conv_b[l], lru_wa[l],
                            lru_ba[l], lru_wx[l], lru_bx[l], lru_lambda[l], hy_conv_w[l], hy_conv_b[l],
                            hy_w1[l], hy_b1[l], hy_w2[l], hy_b2[l], hy_w3[l], hy_decay[l], hy_bias[l],
                            lb, w_branch_out[l], w_out[l])
        h = h + swiglu(rms_norm(h, norm_ffn[l]), ffn_w_gate[l], ffn_w_up[l], ffn_w_down[l])
    return rms_norm(h, norm_final)[:, N_META:]
```

```cpp
#include <hip/hip_runtime.h>
#include <hip/hip_cooperative_groups.h>
#include <cstdio>
namespace cg = cooperative_groups;

#define LAS __attribute__((address_space(3)))
typedef unsigned short bf16_t;
typedef short bf16x8 __attribute__((ext_vector_type(8)));
typedef float f32x4 __attribute__((ext_vector_type(4)));
typedef float f32x2 __attribute__((ext_vector_type(2)));
typedef unsigned u32x4 __attribute__((ext_vector_type(4)));
typedef unsigned u32x2 __attribute__((ext_vector_type(2)));

constexpr int D = 2048, T = 8208, SEQ = 8192, W = 512, MP = 16640, MX = 16384, NMIX = 7168, NGATE = 8192, DFF = 5632, NCHK = 65;
constexpr int GRN = 18576, GROFF = 10240, UBLK = 136, UBT = 95 * 136, TF = 8320, FOFF = 112;
constexpr float EPS = 1e-6f;

constexpr size_t OFF_H = 0;
constexpr size_t OFF_NB = OFF_H + (size_t)MP * D * 4;
constexpr size_t OFF_Z = OFF_NB + (size_t)MP * D * 2;
constexpr size_t OFF_WIN = OFF_Z + (size_t)MP * D * 2;
constexpr size_t OFF_WBO = OFF_WIN + (size_t)15360 * 2048 * 2;
constexpr size_t OFF_WOUT = OFF_WBO + (size_t)4 * 2048 * 512 * 2;
constexpr size_t OFF_WGU = OFF_WOUT + (size_t)2048 * 2048 * 2;
constexpr size_t OFF_WD = OFF_WGU + (size_t)11264 * 2048 * 2;
constexpr size_t OFF_ROPE = OFF_WD + (size_t)2048 * 5632 * 2;
constexpr size_t OFF_R = OFF_ROPE + (size_t)T * 64 * 8;
constexpr size_t R_PMIX = OFF_R;
constexpr size_t R_O = R_PMIX + (size_t)MP * NMIX * 2;
constexpr size_t R_LA = R_O + (size_t)4 * MP * W * 2;
constexpr size_t R_BB = R_LA + (size_t)2 * MP * W * 2;
constexpr size_t R_U = R_BB + (size_t)2 * MP * W * 2;
constexpr size_t R_GG = R_U + (size_t)520 * 65536 * 4;
constexpr size_t R_UT = R_GG + (size_t)520 * 512 * 4;
constexpr size_t R_GR = R_UT + (size_t)512 * 2 * TF * 2;
constexpr size_t R_CA = R_GR + (size_t)512 * GRN * 2;
constexpr size_t R_CB = R_CA + (size_t)4 * 65 * 512 * 4;
constexpr size_t R_CR = R_CB + (size_t)4 * 65 * 512 * 4;
constexpr size_t R_YT = R_CR + (size_t)4 * 65 * 512 * 4;
constexpr size_t R_END1 = R_YT + (size_t)512 * 2 * TF * 2;
constexpr size_t R_G = R_LA;
constexpr size_t R_MB = OFF_R;
constexpr size_t R_FF = OFF_R + (size_t)MP * D * 2;
constexpr size_t WS_NEED = (R_G + (size_t)MP * NGATE * 2) > R_END1 ? (R_G + (size_t)MP * NGATE * 2) : R_END1;
static_assert(R_END1 <= WS_NEED, "scratch");
constexpr size_t OFF_BAR = (WS_NEED + 255) & ~(size_t)255;
constexpr size_t OFF_LRUW = OFF_BAR + 16384;
constexpr size_t OFF_LBT = OFF_LRUW + 262144;
constexpr size_t WS_TOTAL = OFF_LBT + 2048;
static_assert(WS_TOTAL <= (size_t)1006632960, "workspace too large");
static_assert(R_FF + (size_t)MP * DFF * 2 <= WS_NEED, "ff");

struct Params { const float* in[28]; float* out; unsigned char* ws; int rep; int pad; };
typedef const __attribute__((address_space(4))) Params CParams;

__device__ __forceinline__ float bf2f(bf16_t b) { return __uint_as_float(((unsigned)b) << 16); }
typedef __bf16 bf16v2 __attribute__((ext_vector_type(2)));
__device__ __forceinline__ unsigned pk2(float lo, float hi) { const f32x2 v = {lo, hi}; const bf16v2 b = __builtin_convertvector(v, bf16v2); return __builtin_bit_cast(unsigned, b); }
__device__ __forceinline__ unsigned f2bf(float f) { return pk2(f, 0.f) & 0xffffu; }
__device__ __forceinline__ float sigm(float x) { return __builtin_amdgcn_rcpf(1.0f + __expf(-x)); }
__device__ __forceinline__ float siluf(float x) { return x * sigm(x); }
__device__ __forceinline__ float gelu_tanh(float x) { return 0.5f * x * (1.0f + tanhf(0.7978845608028654f * (x + 0.044715f * x * x * x))); }
__device__ __forceinline__ int row_of(int b, int t) { return t < 16 ? (MX + b * 128 + 112 + t) : (b * SEQ + (t - 16)); }
__device__ __forceinline__ int row_bci(int b, int c, int i) { return c == 0 ? (MX + b * 128 + i) : (b * SEQ + (c - 1) * 128 + i); }
__device__ __forceinline__ int opaque_tid() { int t = threadIdx.x; asm volatile("" : "+v"(t)); return t; }
#define LDS_WAIT() asm volatile("s_waitcnt lgkmcnt(0)" ::: "memory")

namespace pg8 {
constexpr int BM = 256, BK = 64, HALF = 128, HTB = HALF * BK * 2, NXCD = 8, WGM = 8;
__device__ __forceinline__ int lds_byte(int r, int c) { const int st = (r >> 4) * 2 + (c >> 5), rr = r & 15, cc = c & 31, ob = rr * 64 + cc * 2; return st * 1024 + (ob ^ (((ob >> 9) & 1) << 5)); }
__device__ __forceinline__ void stage_rc(int b, int& R, int& C) { const int st = b / 1024, sb = b % 1024, swz = sb ^ (((sb >> 9) & 1) << 5); R = (st >> 1) * 16 + swz / 64; C = (st & 1) * 32 + (swz % 64) / 2; }
__device__ __forceinline__ int perm32(int rho) { const int n = rho >> 4, i = rho & 15; return 8 * (i >> 2) + 4 * n + (i & 3); }
struct Unit { int pm, pn, z; };
__device__ __forceinline__ bool tile_of(long L, int nM, int nN, int WGMr, int& pm, int& pn) {
    const int nwg = nM * nN; if (L >= nwg) return false;
    int wgid = (int)L; { const int q = nwg / NXCD, r = nwg % NXCD, xcd = wgid % NXCD, off = wgid / NXCD; wgid = (xcd < r ? xcd * (q + 1) : r * (q + 1) + (xcd - r) * q) + off; }
    const int nig = WGMr * nN, gid = wgid / nig, fm = gid * WGMr, gsz = (nM - fm) < WGMr ? (nM - fm) : WGMr;
    pm = fm + ((wgid % nig) % gsz); pn = (wgid % nig) / gsz; return true;
}
struct PlainSched {
    int nM, nN, G, c; const char* A; const char* B; size_t at, bt; int wgm;
    __device__ __forceinline__ bool next(int i, Unit& u) const { u.z = 0; return tile_of((long)i * G + c, nM, nN, wgm, u.pm, u.pn); }
    __device__ __forceinline__ const char* aptr(const Unit& u) const { return A + (size_t)u.pm * at; }
    __device__ __forceinline__ const char* bptr(const Unit& u) const { return B + (size_t)u.pn * bt; }
};
struct BranchSched {
    int nM, nN, G, c; const char* A; const char* B; size_t at, bt; int wgm;
    __device__ __forceinline__ bool next(int i, Unit& u) const { u.z = i & 3; return tile_of((long)(i >> 2) * G + c, nM, nN, wgm, u.pm, u.pn); }
    __device__ __forceinline__ const char* aptr(const Unit& u) const { return A + (size_t)u.pm * at + (size_t)u.z * (W * 2); }
    __device__ __forceinline__ const char* bptr(const Unit& u) const { return B + (size_t)u.z * ((size_t)D * W * 2) + (size_t)u.pn * bt; }
};

template <int ACT> struct EpiBf16 {
    static constexpr bool PERM = true;
    bf16_t* O; int ldc;
    __device__ __forceinline__ void operator()(const f32x4 (&acc)[2][2][4][2], const Unit& u, int wr, int wc, int fr, int fq) const {
        const int row0 = u.pm * BM + wr * 64 + fr, col0 = u.pn * BM + wc * 32 + 8 * fq;
#pragma unroll
        for (int ai = 0; ai < 2; ++ai)
#pragma unroll
            for (int m = 0; m < 4; ++m) { bf16_t* rowp = O + (size_t)(row0 + ai * HALF + m * 16) * ldc + col0;
#pragma unroll
                for (int bj = 0; bj < 2; ++bj) { f32x4 v0 = acc[ai][bj][m][0], v1 = acc[ai][bj][m][1];
                    if (ACT == 1) {
#pragma unroll
                        for (int j = 0; j < 4; ++j) { v0[j] = sigm(v0[j]); v1[j] = sigm(v1[j]); } }
                    u32x4 w; w.x = pk2(v0[0], v0[1]); w.y = pk2(v0[2], v0[3]); w.z = pk2(v1[0], v1[1]); w.w = pk2(v1[2], v1[3]);
                    *(u32x4*)(rowp + bj * HALF) = w; } }
    }
};
struct EpiBranch {
    static constexpr bool PERM = true;
    bf16_t* MB; const bf16_t* G;
    __device__ __forceinline__ void operator()(const f32x4 (&acc)[2][2][4][2], const Unit& u, int wr, int wc, int fr, int fq) const {
        const int row0 = u.pm * BM + wr * 64 + fr, col0 = u.pn * BM + wc * 32 + 8 * fq;
#pragma unroll
        for (int ai = 0; ai < 2; ++ai)
#pragma unroll
          for (int mp = 0; mp < 2; ++mp) {
            u32x4 g[2][2], pv[2][2];
#pragma unroll
            for (int mm = 0; mm < 2; ++mm)
#pragma unroll
                for (int bj = 0; bj < 2; ++bj) { const size_t r = (size_t)(row0 + ai * HALF + (2 * mp + mm) * 16);
                    g[mm][bj] = *(const u32x4*)(G + r * NGATE + u.z * D + col0 + bj * HALF);
                    pv[mm][bj] = (u32x4){0u, 0u, 0u, 0u}; if (u.z) pv[mm][bj] = *(const u32x4*)(MB + r * D + col0 + bj * HALF); }
#pragma unroll
            for (int mm = 0; mm < 2; ++mm)
#pragma unroll
                for (int bj = 0; bj < 2; ++bj) { const int m = 2 * mp + mm; const size_t r = (size_t)(row0 + ai * HALF + m * 16);
                    const f32x4 v0 = acc[ai][bj][m][0], v1 = acc[ai][bj][m][1];
                    float o[8];
                    o[0] = v0[0]; o[1] = v0[1]; o[2] = v0[2]; o[3] = v0[3]; o[4] = v1[0]; o[5] = v1[1]; o[6] = v1[2]; o[7] = v1[3];
                    u32x4 w;
#pragma unroll
                    for (int q = 0; q < 4; ++q) {
                        const float g0 = sigm(__uint_as_float(g[mm][bj][q] << 16)), g1 = sigm(__uint_as_float(g[mm][bj][q] & 0xffff0000u));
                        const float p0 = __uint_as_float(pv[mm][bj][q] << 16), p1 = __uint_as_float(pv[mm][bj][q] & 0xffff0000u);
                        w[q] = pk2(p0 + g0 * o[2 * q], p1 + g1 * o[2 * q + 1]); }
                    *(u32x4*)(MB + r * D + col0 + bj * HALF) = w; } }
    }
};
struct EpiResid {
    static constexpr bool PERM = false;
    float* H; const float* S;
    __device__ __forceinline__ void operator()(const f32x4 (&acc)[2][2][4][2], const Unit& u, int wr, int wc, int fr, int fq) const {
        const int row0 = u.pm * BM + wr * 64 + fr, col0 = u.pn * BM + wc * 32 + 4 * fq;
#pragma unroll
        for (int ai = 0; ai < 2; ++ai)
#pragma unroll
            for (int mp = 0; mp < 2; ++mp) {
                f32x4 old[2][2][2];
#pragma unroll
                for (int mm = 0; mm < 2; ++mm)
#pragma unroll
                    for (int bj = 0; bj < 2; ++bj)
#pragma unroll
                        for (int n = 0; n < 2; ++n) old[mm][bj][n] = *(const f32x4*)(S + (size_t)(row0 + ai * HALF + (2 * mp + mm) * 16) * D + col0 + bj * HALF + n * 16);
#pragma unroll
                for (int mm = 0; mm < 2; ++mm)
#pragma unroll
                    for (int bj = 0; bj < 2; ++bj)
#pragma unroll
                        for (int n = 0; n < 2; ++n) *(f32x4*)(H + (size_t)(row0 + ai * HALF + (2 * mp + mm) * 16) * D + col0 + bj * HALF + n * 16) = old[mm][bj][n] + acc[ai][bj][2 * mp + mm][n]; }
    }
};
struct EpiSwiglu {
    static constexpr bool PERM = true;
    bf16_t* FF;
    __device__ __forceinline__ void operator()(const f32x4 (&acc)[2][2][4][2], const Unit& u, int wr, int wc, int fr, int fq) const {
        const int row0 = u.pm * BM + wr * 64 + fr, col0 = u.pn * HALF + wc * 32 + 8 * fq;
#pragma unroll
        for (int ai = 0; ai < 2; ++ai)
#pragma unroll
            for (int m = 0; m < 4; ++m) { bf16_t* rowp = FF + (size_t)(row0 + ai * HALF + m * 16) * DFF + col0;
                const f32x4 g0 = acc[ai][0][m][0], g1 = acc[ai][0][m][1], u0 = acc[ai][1][m][0], u1 = acc[ai][1][m][1];
                u32x4 w; w.x = pk2(siluf(g0[0]) * u0[0], siluf(g0[1]) * u0[1]); w.y = pk2(siluf(g0[2]) * u0[2], siluf(g0[3]) * u0[3]);
                w.z = pk2(siluf(g1[0]) * u1[0], siluf(g1[1]) * u1[1]); w.w = pk2(siluf(g1[2]) * u1[2], siluf(g1[3]) * u1[3]);
                *(u32x4*)rowp = w; }
    }
};

template <class Epi, class Sched>
__device__ __forceinline__ void gemm_phase(LAS unsigned char* lds, const int lda, const int ldb, const int K, const Sched& S, const Epi& E) {
    const int tid = opaque_tid(), wid = __builtin_amdgcn_readfirstlane(tid >> 6), lane = tid & 63, wr = wid >> 2, wc = wid & 3, fr = lane & 15, fq = lane >> 4;
    const int nt = K / BK;
    unsigned voffA[2], voffB[2];
#pragma unroll
    for (int i = 0; i < 2; ++i) { int R, C; stage_rc(tid * 16 + i * 8192, R, C); const int Rb = Epi::PERM ? ((R & ~31) + perm32(R & 31)) : R;
        voffA[i] = (unsigned)(R * lda + C) * 2u; voffB[i] = (unsigned)(Rb * ldb + C) * 2u; }
    const size_t kstep = (size_t)(BK * 2);
    const size_t hstepA = (size_t)HALF * lda * 2, hstepB = (size_t)HALF * ldb * 2;
    const unsigned ldsw = (unsigned)wid * 1024u;
    const int aoff = lds_byte(wr * 64 + fr, fq * 8), boff = lds_byte(wc * 32 + fr, fq * 8);
#define PG8_SA(b, h) (((b) * 2 + (h)) * HTB)
#define PG8_SB(b, h) ((4 + (b) * 2 + (h)) * HTB)
#define PG8_STAGE(bufoff, gbase, voff) do { _Pragma("unroll") for (int _i = 0; _i < 2; ++_i) \
        __builtin_amdgcn_global_load_lds((const unsigned*)((const char*)(gbase) + (voff)[_i]), (LAS unsigned*)(lds + (bufoff) + ldsw + _i * 8192), 16, 0, 0); } while (0)
#define PG8_LDA(dst, b, h) do { _Pragma("unroll") for (int m = 0; m < 4; ++m) _Pragma("unroll") for (int k = 0; k < 2; ++k) dst[m][k] = *(const LAS bf16x8*)(lds + PG8_SA(b, h) + aoff + m * 2048 + k * 1024); } while (0)
#define PG8_LDB(dst, b, h) do { _Pragma("unroll") for (int n = 0; n < 2; ++n) _Pragma("unroll") for (int k = 0; k < 2; ++k) dst[n][k] = *(const LAS bf16x8*)(lds + PG8_SB(b, h) + boff + n * 2048 + k * 1024); } while (0)
#define PG8_MMA(ai, bj, At, Bt) do { __builtin_amdgcn_s_setprio(1); _Pragma("unroll") for (int m = 0; m < 4; ++m) _Pragma("unroll") for (int n = 0; n < 2; ++n) _Pragma("unroll") for (int k = 0; k < 2; ++k) \
        acc[ai][bj][m][n] = __builtin_amdgcn_mfma_f32_16x16x32_bf16(Bt[n][k], At[m][k], acc[ai][bj][m][n], 0, 0, 0); __builtin_amdgcn_s_setprio(0); } while (0)
#define PG8_WAIT_V(n) asm volatile("s_waitcnt vmcnt(" #n ")" ::: "memory")
#define PG8_WAIT_L(n) asm volatile("s_waitcnt lgkmcnt(" #n ")" ::: "memory")
#define PG8_BAR __builtin_amdgcn_s_barrier()
#define PG8_SCHED __builtin_amdgcn_sched_barrier(0)
    Unit cur, nxt; int ui = 0;
    if (!S.next(0, cur)) return;
    f32x4 acc[2][2][4][2];
#pragma unroll
    for (int a = 0; a < 2; ++a)
#pragma unroll
        for (int b = 0; b < 2; ++b)
#pragma unroll
            for (int m = 0; m < 4; ++m)
#pragma unroll
                for (int n = 0; n < 2; ++n) acc[a][b][m][n] = (f32x4){0.f, 0.f, 0.f, 0.f};
    bf16x8 At[4][2], B0[2][2], B1[2][2];
    const char* cA = S.aptr(cur); const char* cB = S.bptr(cur);
    PG8_STAGE(PG8_SB(0, 0), cB, voffB); PG8_STAGE(PG8_SA(0, 0), cA, voffA); PG8_STAGE(PG8_SB(0, 1), cB + hstepB, voffB); PG8_STAGE(PG8_SA(0, 1), cA + hstepA, voffA);
    if (wr == 1) PG8_BAR;
    PG8_WAIT_V(4); PG8_BAR;
    PG8_STAGE(PG8_SB(1, 0), cB + kstep, voffB); PG8_STAGE(PG8_SA(1, 0), cA + kstep, voffA); PG8_STAGE(PG8_SB(1, 1), cB + hstepB + kstep, voffB);
    PG8_WAIT_V(6); PG8_BAR;
    for (;;) {
        const bool has_next = S.next(ui + 1, nxt);
        const char* nA = has_next ? S.aptr(nxt) : cA; const char* nB = has_next ? S.bptr(nxt) : cB;
        for (int t = 0; t < nt; t += 2) {
            const bool last = (t == nt - 2);
            const char* a1 = cA + (size_t)(t + 1) * kstep;
            const char* a2 = last ? nA : cA + (size_t)(t + 2) * kstep; const char* b2 = last ? nB : cB + (size_t)(t + 2) * kstep;
            const char* a3 = a2 + kstep; const char* b3 = b2 + kstep;
            PG8_LDB(B0, 0, 0); PG8_SCHED; PG8_LDA(At, 0, 0); PG8_STAGE(PG8_SA(1, 1), a1 + hstepA, voffA);
            PG8_WAIT_L(8); PG8_BAR; PG8_WAIT_L(0); PG8_MMA(0, 0, At, B0); PG8_BAR; PG8_SCHED;
            PG8_LDB(B1, 0, 1); PG8_STAGE(PG8_SB(0, 0), b2, voffB);
            PG8_BAR; PG8_WAIT_L(0); PG8_MMA(0, 1, At, B1); PG8_BAR;
            PG8_LDA(At, 0, 1); PG8_STAGE(PG8_SA(0, 0), a2, voffA);
            PG8_BAR; PG8_WAIT_L(0); PG8_MMA(1, 0, At, B0); PG8_BAR; PG8_SCHED;
            PG8_STAGE(PG8_SB(0, 1), b2 + hstepB, voffB);
            PG8_WAIT_V(6); PG8_BAR; PG8_MMA(1, 1, At, B1); PG8_BAR;
            PG8_LDB(B0, 1, 0); PG8_SCHED; PG8_LDA(At, 1, 0); PG8_STAGE(PG8_SA(0, 1), a2 + hstepA, voffA);
            PG8_WAIT_L(8); PG8_BAR; PG8_WAIT_L(0); PG8_MMA(0, 0, At, B0); PG8_BAR; PG8_SCHED;
            PG8_LDB(B1, 1, 1); PG8_STAGE(PG8_SB(1, 0), b3, voffB);
            PG8_BAR; PG8_WAIT_L(0); PG8_MMA(0, 1, At, B1); PG8_BAR;
            PG8_LDA(At, 1, 1); PG8_STAGE(PG8_SA(1, 0), a3, voffA);
            PG8_BAR; PG8_WAIT_L(0); PG8_MMA(1, 0, At, B0); PG8_BAR; PG8_SCHED;
            PG8_STAGE(PG8_SB(1, 1), b3 + hstepB, voffB);
            PG8_WAIT_V(6); PG8_BAR; PG8_MMA(1, 1, At, B1); PG8_BAR;
        }
        E(acc, cur, wr, wc, fr, fq);
        if (!has_next) break;
#pragma unroll
        for (int a = 0; a < 2; ++a)
#pragma unroll
            for (int b = 0; b < 2; ++b)
#pragma unroll
                for (int m = 0; m < 4; ++m)
#pragma unroll
                    for (int n = 0; n < 2; ++n) acc[a][b][m][n] = (f32x4){0.f, 0.f, 0.f, 0.f};
        cur = nxt; cA = nA; cB = nB; ++ui;
    }
    PG8_WAIT_V(0);
    if (wr == 0) PG8_BAR;
    PG8_BAR;
#undef PG8_SA
#undef PG8_SB
#undef PG8_STAGE
#undef PG8_LDA
#undef PG8_LDB
#undef PG8_MMA
#undef PG8_WAIT_V
#undef PG8_WAIT_L
#undef PG8_BAR
#undef PG8_SCHED
}
}

struct XpItem { const float* src; bf16_t* dst; int K, N, k0, n0, row0; };
__device__ __forceinline__ void xpose_load(const XpItem& x, int lane, f32x4 (&v)[8]) {
#pragma unroll
    for (int i = 0; i < 8; ++i) v[i] = *(const f32x4*)(x.src + (size_t)(x.k0 + 8 * i + (lane >> 3)) * x.N + x.n0 + (lane & 7) * 4);
}
__device__ __forceinline__ void xpose_finish(const XpItem& x, int lane, const f32x4 (&v)[8], LAS float* scr) {
#pragma unroll
    for (int i = 0; i < 8; ++i) { LAS float* d = scr + (8 * i + (lane >> 3)) * 33 + (lane & 7) * 4; d[0] = v[i][0]; d[1] = v[i][1]; d[2] = v[i][2]; d[3] = v[i][3]; }
    LDS_WAIT(); asm volatile("" ::: "memory");
    const int c = lane & 7;
#pragma unroll
    for (int j = 0; j < 4; ++j) { const int n = (lane >> 3) + 8 * j; const LAS float* s = scr + (8 * c) * 33 + n;
        u32x4 o; o.x = pk2(s[0 * 33], s[1 * 33]); o.y = pk2(s[2 * 33], s[3 * 33]); o.z = pk2(s[4 * 33], s[5 * 33]); o.w = pk2(s[6 * 33], s[7 * 33]);
        *(u32x4*)(x.dst + (size_t)(x.row0 + n) * x.K + x.k0 + 8 * c) = o; }
    LDS_WAIT(); asm volatile("" ::: "memory");
}

__device__ __forceinline__ float wave_sum(float v) {
#pragma unroll
    for (int o = 1; o < 64; o <<= 1) v += __shfl_xor(v, o);
    return v;
}

__device__ __forceinline__ void norm_rows(CParams& p, int mode, const float* gain, int nrows) {
    float* H = (float*)(p.ws + OFF_H); bf16_t* NB = (bf16_t*)(p.ws + OFF_NB);
    const int tid0 = opaque_tid(); const int lane = tid0 & 63, gw = blockIdx.x * 8 + (tid0 >> 6), NW = gridDim.x * 8;
    for (int row = gw; row < nrows; row += NW) {
        f32x4 v[8];
        if (mode == 0) {
            const float* src = nullptr;
            if (row < MX) src = p.in[0] + (size_t)row * D;
            else { const int i = (row - MX) & 127; if (i >= 112) src = p.in[1] + (size_t)(i - 112) * D; }
#pragma unroll
            for (int j = 0; j < 8; ++j) { v[j] = src ? *(const f32x4*)(src + (lane + 64 * j) * 4) : (f32x4){0.f, 0.f, 0.f, 0.f}; if (row >= MX) *(f32x4*)(H + (size_t)row * D + (lane + 64 * j) * 4) = v[j]; }
        } else {
#pragma unroll
            for (int j = 0; j < 8; ++j) v[j] = *(const f32x4*)(H + (size_t)row * D + (lane + 64 * j) * 4);
        }
        float s = 0.f;
#pragma unroll
        for (int j = 0; j < 8; ++j) s += (v[j][0] * v[j][0] + v[j][1] * v[j][1]) + (v[j][2] * v[j][2] + v[j][3] * v[j][3]);
        const float rs = 1.0f / sqrtf(wave_sum(s) * (1.0f / D) + EPS);
#pragma unroll
        for (int j = 0; j < 8; ++j) {
            const f32x4 g = *(const f32x4*)(gain + (lane + 64 * j) * 4);
            const f32x4 y = v[j] * rs * g;
            if (mode == 3) *(f32x4*)(p.out + (size_t)row * D + (lane + 64 * j) * 4) = y;
            else { u32x2 w; w.x = pk2(y[0], y[1]); w.y = pk2(y[2], y[3]); *(u32x2*)(NB + (size_t)row * D + (lane + 64 * j) * 4) = w; }
        }
    }
}

constexpr int FPOS = 36;
__device__ __forceinline__ void filter_item(CParams& p, int layer, int it, LAS float* l) {
    LAS float* Zf = l; LAS float* H1 = l + FPOS * 33; LAS float* H2T = H1 + FPOS * 64;
    LAS float* W1L = H2T + 64 * FPOS; LAS float* W2L = W1L + 33 * 64;
    const int tid = opaque_tid(), n0 = it * FPOS;
    const float* w1 = p.in[14] + layer * 33 * 64; const float* b1 = p.in[15] + layer * 64; const float* w2 = p.in[16] + layer * 64 * 64;
    const float* b2 = p.in[17] + layer * 64; const float* w3 = p.in[18] + layer * 64 * 1024; const float* decay = p.in[19] + layer * 1024;
    bf16_t* GR = (bf16_t*)(p.ws + R_GR);
    __syncthreads();
    {
        const f32x4 t0 = *(const f32x4*)(w1 + 4 * tid), t2 = *(const f32x4*)(w2 + 4 * tid), t3 = *(const f32x4*)(w2 + 2048 + 4 * tid);
        f32x4 t1 = (f32x4){0.f, 0.f, 0.f, 0.f}; if (tid < 16) t1 = *(const f32x4*)(w1 + 2048 + 4 * tid);
        *(LAS f32x4*)(W1L + 4 * tid) = t0; if (tid < 16) *(LAS f32x4*)(W1L + 2048 + 4 * tid) = t1;
        *(LAS f32x4*)(W2L + 4 * tid) = t2; *(LAS f32x4*)(W2L + 2048 + 4 * tid) = t3; }
    for (int idx = tid; idx < FPOS * 33; idx += 512) { const int pos = idx / 33, e = idx % 33, n = n0 + pos; float v;
        if (e == 0) v = (float)n / 8207.0f;
        else { const int k = (e - 1) & 15; const float fr = 1e-4f + (float)k * ((15.0f - 1e-4f) / 15.0f); const double rev = (double)n * (double)fr * (1.0 / 8208.0); const float fx = (float)(rev - floor(rev));
               v = (e <= 16) ? __builtin_amdgcn_cosf(fx) : -__builtin_amdgcn_sinf(fx); }
        Zf[pos * 33 + e] = v; }
    __syncthreads();
    for (int pos = tid >> 4; pos < FPOS; pos += 32) { const int k4 = (tid & 15) * 4; float a[4];
#pragma unroll
      for (int q = 0; q < 4; ++q) a[q] = b1[k4 + q];
#pragma unroll 3
      for (int e = 0; e < 33; ++e) { const float z = Zf[pos * 33 + e];
#pragma unroll
          for (int q = 0; q < 4; ++q) a[q] += z * W1L[e * 64 + k4 + q]; }
#pragma unroll
      for (int q = 0; q < 4; ++q) H1[pos * 64 + k4 + q] = __builtin_amdgcn_sinf(a[q] * 0.15915494309189535f); }
    __syncthreads();
    for (int pos = tid >> 4; pos < FPOS; pos += 32) { const int k4 = (tid & 15) * 4; float a[4];
#pragma unroll
      for (int q = 0; q < 4; ++q) a[q] = b2[k4 + q];
#pragma unroll 4
      for (int j = 0; j < 64; ++j) { const float z = H1[pos * 64 + j];
#pragma unroll
          for (int q = 0; q < 4; ++q) a[q] += z * W2L[j * 64 + k4 + q]; }
#pragma unroll
      for (int q = 0; q < 4; ++q) H2T[(k4 + q) * FPOS + pos] = __builtin_amdgcn_sinf(a[q] * 0.15915494309189535f); }
    __syncthreads();
    { float acc0[FPOS], acc1[FPOS];
#pragma unroll
      for (int q = 0; q < FPOS; ++q) { acc0[q] = 0.f; acc1[q] = 0.f; }
#pragma unroll 1
      for (int k8 = 0; k8 < 64; k8 += 8) { float wa8[8], wb8[8];
#pragma unroll
        for (int kk = 0; kk < 8; ++kk) { wa8[kk] = w3[(k8 + kk) * 1024 + tid]; wb8[kk] = w3[(k8 + kk) * 1024 + 512 + tid]; }
#pragma unroll
        for (int kk = 0; kk < 8; ++kk) { const int k = k8 + kk; const float wa = wa8[kk], wb = wb8[kk];
#pragma unroll
          for (int p4 = 0; p4 < FPOS / 4; ++p4) { const f32x4 h = *(const LAS f32x4*)(H2T + k * FPOS + p4 * 4);
#pragma unroll
              for (int q = 0; q < 4; ++q) { acc0[4 * p4 + q] += h[q] * wa; acc1[4 * p4 + q] += h[q] * wb; } } } }
      const float da = fabsf(decay[tid]), db = fabsf(decay[512 + tid]);
      static_assert(T % FPOS == 0 && FPOS % 4 == 0 && (GROFF % 4) == 0, "filter store grouping");
      bf16_t* gf = GR + (size_t)tid * GRN + (GROFF - n0);
      bf16_t* gb = GR + (size_t)tid * GRN + (GROFF + n0);
      const float sa = -da / 8207.0f, sb = -db / 8207.0f;
#define FE0(q) (acc0[q] * __expf(sa * (float)(n0 + (q))))
#define FE1(q) (acc1[q] * __expf(sb * (float)(n0 + (q))))
      gf[0] = (bf16_t)f2bf(FE0(0));
#pragma unroll
      for (int k = 1; k <= 8; ++k) { u32x2 w; w.x = pk2(FE0(4 * k), FE0(4 * k - 1)); w.y = pk2(FE0(4 * k - 2), FE0(4 * k - 3)); *(u32x2*)(gf - 4 * k) = w; }
      *(unsigned*)(gf - 34) = pk2(FE0(34), FE0(33));
      gf[-35] = (bf16_t)f2bf(FE0(35));
      if (it == 0) { gb[1] = (bf16_t)f2bf(FE1(1)); gb[2] = (bf16_t)f2bf(FE1(2)); gb[3] = (bf16_t)f2bf(FE1(3)); }
      else { u32x2 w; w.x = pk2(FE1(0), FE1(1)); w.y = pk2(FE1(2), FE1(3)); *(u32x2*)gb = w; }
#pragma unroll
      for (int k = 1; k < 9; ++k) { u32x2 w; w.x = pk2(FE1(4 * k), FE1(4 * k + 1)); w.y = pk2(FE1(4 * k + 2), FE1(4 * k + 3)); *(u32x2*)(gb + 4 * k) = w; }
#undef FE0
#undef FE1
    }
}

__device__ __forceinline__ void phase_prep(CParams& p, int layer, LAS unsigned char* lds) {
    const int tid = opaque_tid(), lane = tid & 63, wave = tid >> 6;
    for (int it = blockIdx.x; it < (T + FPOS - 1) / FPOS; it += gridDim.x) filter_item(p, layer, it, (LAS float*)lds);
    __syncthreads();
    if (layer == 0) {
        f32x2* RT = (f32x2*)(p.ws + OFF_ROPE);
        for (int idx = blockIdx.x * 512 + tid; idx < T * 64; idx += gridDim.x * 512) { const int pos = idx >> 6, j = idx & 63;
            double inv = 1.0; for (int q = 0; q < j; ++q) inv *= 0.8659643233600653; const double rev = (double)pos * inv * 0.15915494309189535; const float fx = (float)(rev - floor(rev));
            RT[idx] = (f32x2){__builtin_amdgcn_cosf(fx), __builtin_amdgcn_sinf(fx)}; }
    }
    if (blockIdx.x == 0) { const float l0 = p.in[21][tid], l1 = p.in[21][W + tid]; ((float*)(p.ws + OFF_LBT))[tid] = (layer == 1) ? 1.0f / (1.0f + expf(l0 - l1)) : 0.f; }
    { bf16_t* Wg = (bf16_t*)(p.ws + OFF_LRUW);
      for (int idx = blockIdx.x * 512 + tid; idx < 131072; idx += gridDim.x * 512) { const int i = idx & 63, jj = (idx >> 6) & 63, kb = (idx >> 12) & 7, m = idx >> 15;
          const float* src = (m & 1) ? p.in[9] : p.in[7]; Wg[idx] = (bf16_t)f2bf(src[(size_t)((layer * 2 + (m >> 1)) * 8 + kb) * 4096 + i * 64 + jj]); } }
    LAS float* scr = (LAS float*)lds + wave * (64 * 33);
    const int gw = blockIdx.x * 8 + wave, NW = gridDim.x * 8;
    constexpr int I_IN = 32 * 480, I_BO = 8 * 64, I_OUT = 32 * 64, I_G = 32 * 176, I_D = 88 * 64;
    constexpr int NIT = I_IN + 4 * I_BO + I_OUT + 2 * I_G + I_D;
    auto decode = [&](int it, XpItem& x) {
        int r = it;
        if (r < I_IN) { const int nb = r % 480, kb = r / 480; x = XpItem{p.in[4] + (size_t)layer * D * 15360, (bf16_t*)(p.ws + OFF_WIN), D, 15360, kb * 64, nb * 32, nb * 32}; return; } r -= I_IN;
        if (r < 4 * I_BO) { const int z = r / I_BO, q = r % I_BO, nb = q % 64, kb = q / 64;
            x = XpItem{p.in[22] + ((size_t)layer * 4 + z) * W * D, (bf16_t*)(p.ws + OFF_WBO) + (size_t)z * D * W, W, D, kb * 64, nb * 32, nb * 32}; return; } r -= 4 * I_BO;
        if (r < I_OUT) { const int nb = r % 64, kb = r / 64; x = XpItem{p.in[23] + (size_t)layer * D * D, (bf16_t*)(p.ws + OFF_WOUT), D, D, kb * 64, nb * 32, nb * 32}; return; } r -= I_OUT;
        if (r < 2 * I_G) { const int up = r / I_G, q = r % I_G, nb = q % 176, kb = q / 176, n0 = nb * 32;
            x = XpItem{p.in[up ? 25 : 24] + (size_t)layer * D * DFF, (bf16_t*)(p.ws + OFF_WGU), D, DFF, kb * 64, n0, 256 * (n0 >> 7) + (n0 & 127) + up * 128}; return; } r -= 2 * I_G;
        { const int nb = r % 64, kb = r / 64; x = XpItem{p.in[26] + (size_t)layer * DFF * D, (bf16_t*)(p.ws + OFF_WD), DFF, D, kb * 64, nb * 32, nb * 32}; }
    };
    {
        XpItem cur, nxt; f32x4 vc[8], vn[8];
        int it = gw;
        if (it < NIT) { decode(it, cur); xpose_load(cur, lane, vc); }
        for (; it < NIT; it += NW) {
            const bool hn = (it + NW) < NIT;
            if (hn) { decode(it + NW, nxt); xpose_load(nxt, lane, vn); }
            xpose_finish(cur, lane, vc, scr);
            if (hn) { cur = nxt;
#pragma unroll
                for (int i = 0; i < 8; ++i) vc[i] = vn[i]; }
        }
    }
    norm_rows(p, layer == 0 ? 0 : 1, p.in[2] + layer * D, MP);
}

__device__ __forceinline__ void lru_s1_item(CParams& p, int layer, int item, LAS unsigned char* lds) {
    const int cidx = item >> 3, kb = item & 7, b = cidx / NCHK, c = cidx % NCHK;
    const int tid = opaque_tid(), lane = tid & 63, wave = tid >> 6;
    constexpr int XS = 72;
    LAS bf16_t* XCb = (LAS bf16_t*)lds;
    LAS bf16_t* WT = XCb + 128 * XS;
    LAS float* XCf = (LAS float*)(lds + (128 + 256) * XS * 2);
    LAS float* AG = XCf + 8192;
    const bf16_t* P = (const bf16_t*)(p.ws + R_PMIX);
    bf16_t* LA = (bf16_t*)(p.ws + R_LA); bf16_t* BB = (bf16_t*)(p.ws + R_BB);
    __syncthreads();
    {
        const bf16_t* Wg = (const bf16_t*)(p.ws + OFF_LRUW);
        for (int q = tid; q < 2048; q += 512) { const int n = q >> 3, part = q & 7, m = n >> 6, jj = n & 63;
            *(LAS u32x4*)(WT + n * XS + part * 8) = *(const u32x4*)(Wg + ((size_t)(m * 8 + kb) * 64 + jj) * 64 + part * 8); } }
    {
        const int j = tid & 63, tq = tid >> 6, ch = kb * 64 + j;
        const float* cw = p.in[5] + layer * 4 * W; const float cb = p.in[6][layer * W + ch];
        const float w0 = cw[ch], w1 = cw[W + ch], w2 = cw[2 * W + ch], w3 = cw[3 * W + ch];
        const int t0 = c * 128 + 16 * tq - 112;
        float xv[19];
#pragma unroll
        for (int q = 0; q < 19; ++q) { const int t = t0 - 2 + q; xv[q] = (t >= 0 && t < T) ? bf2f(P[(size_t)row_of(b, t) * NMIX + ch]) : 0.f; }
#pragma unroll
        for (int tt = 0; tt < 16; ++tt) { const float x = cb + w0 * xv[tt] + w1 * xv[tt + 1] + w2 * xv[tt + 2] + w3 * xv[tt + 3];
            XCf[(16 * tq + tt) * 64 + j] = x; XCb[(16 * tq + tt) * XS + j] = (bf16_t)f2bf(x); } }
    __syncthreads();
    const int r = lane & 15, h = lane >> 4;
    f32x4 acc[16];
#pragma unroll
    for (int nt = 0; nt < 16; ++nt) acc[nt] = (f32x4){0.f, 0.f, 0.f, 0.f};
#pragma unroll
    for (int ks = 0; ks < 2; ++ks) { const bf16x8 a = *(const LAS bf16x8*)(XCb + (16 * wave + r) * XS + 32 * ks + 8 * h);
#pragma unroll
        for (int nt = 0; nt < 16; ++nt) { const bf16x8 bw = *(const LAS bf16x8*)(WT + (16 * nt + r) * XS + 32 * ks + 8 * h);
            acc[nt] = __builtin_amdgcn_mfma_f32_16x16x32_bf16(a, bw, acc[nt], 0, 0, 0); } }
    const int tok0 = 16 * wave + 4 * h, t0 = c * 128 + tok0 - 112;
#pragma unroll
    for (int jt = 0; jt < 4; ++jt) { const int j = 16 * jt + r, ch = kb * 64 + j;
#pragma unroll
        for (int dir = 0; dir < 2; ++dir) {
            const float ba = p.in[8][(layer * 2 + dir) * W + ch], bx = p.in[10][(layer * 2 + dir) * W + ch], lam = p.in[11][(layer * 2 + dir) * W + ch];
            const float sp = log1pf(expf(-lam));
            float Aq = 1.f, Bq = 0.f;
#pragma unroll
            for (int s = 0; s < 4; ++s) { const int q = dir ? 3 - s : s;
                const float rg = sigm(acc[(2 * dir) * 4 + jt][q] + ba), ig = sigm(acc[(2 * dir + 1) * 4 + jt][q] + bx);
                float la = -8.0f * rg * sp; float bv = sqrtf(fmaxf(1.0f - __expf(2.0f * la), 0.f)) * ig * XCf[(tok0 + q) * 64 + j];
                if ((t0 + q) < 0) { la = 0.f; bv = 0.f; }
                const unsigned lab = f2bf(la), bvb = f2bf(bv);
                const size_t ro = (size_t)row_bci(b, c, tok0 + q) * W + ch;
                LA[(size_t)dir * MP * W + ro] = (bf16_t)lab; BB[(size_t)dir * MP * W + ro] = (bf16_t)bvb;
                const float a = __expf(__uint_as_float(lab << 16)), bq = __uint_as_float(bvb << 16);
                Bq = a * Bq + bq; Aq *= a; }
            const int g = 4 * wave + h;
            AG[((g * 2 + dir) * 2 + 0) * 64 + j] = Aq; AG[((g * 2 + dir) * 2 + 1) * 64 + j] = Bq; } }
    __syncthreads();
    if (tid < 128) { const int dir = tid >> 6, jj = tid & 63; float At = 1.f, Bt = 0.f;
        for (int s = 0; s < 32; ++s) { const int q = dir ? 31 - s : s; const float a = AG[((q * 2 + dir) * 2 + 0) * 64 + jj], bq = AG[((q * 2 + dir) * 2 + 1) * 64 + jj]; Bt = a * Bt + bq; At *= a; }
        const size_t o = (size_t)((dir * 2 + b) * NCHK + c) * W + kb * 64 + jj;
        ((float*)(p.ws + R_CA))[o] = At; ((float*)(p.ws + R_CB))[o] = Bt; }
}

__device__ __forceinline__ void lru_carry(CParams& p) {
    const int gt = blockIdx.x * 512 + opaque_tid();
    if (gt < 2048) { const int dir = gt >> 10, b = (gt >> 9) & 1, ch = gt & 511;
        const float* CA = (const float*)(p.ws + R_CA); const float* CB = (const float*)(p.ws + R_CB); float* CR = (float*)(p.ws + R_CR);
        const size_t base = (size_t)((dir * 2 + b) * NCHK) * W + ch; float h = 0.f;
        for (int s0 = 0; s0 < NCHK; s0 += 5) { float a[5], bq[5];
#pragma unroll
            for (int q = 0; q < 5; ++q) { const int c = dir ? NCHK - 1 - (s0 + q) : (s0 + q); a[q] = CA[base + (size_t)c * W]; bq[q] = CB[base + (size_t)c * W]; }
#pragma unroll
            for (int q = 0; q < 5; ++q) { const int c = dir ? NCHK - 1 - (s0 + q) : (s0 + q); CR[base + (size_t)c * W] = h; h = a[q] * h + bq[q]; } } }
}

__device__ __forceinline__ void lru_s3_item(CParams& p, int item, LAS unsigned char* lds) {
    const int cidx = item >> 3, kb = item & 7, b = cidx / NCHK, c = cidx % NCHK;
    const int tid = opaque_tid(), j = tid & 63, tq = tid >> 6, ch = kb * 64 + j;
    LAS float* AG = (LAS float*)lds;
    const bf16_t* P = (const bf16_t*)(p.ws + R_PMIX); const bf16_t* LA = (const bf16_t*)(p.ws + R_LA); const bf16_t* BB = (const bf16_t*)(p.ws + R_BB);
    bf16_t* Z = (bf16_t*)(p.ws + OFF_Z);
    float av[2][16], bv[2][16];
    size_t ro[16];
#pragma unroll
    for (int tt = 0; tt < 16; ++tt) ro[tt] = (size_t)row_bci(b, c, 16 * tq + tt);
#pragma unroll
    for (int dir = 0; dir < 2; ++dir)
#pragma unroll
        for (int tt = 0; tt < 16; ++tt) { const size_t o = (size_t)dir * MP * W + ro[tt] * W + ch; av[dir][tt] = bf2f(LA[o]); bv[dir][tt] = bf2f(BB[o]); }
    __syncthreads();
#pragma unroll
    for (int dir = 0; dir < 2; ++dir) { float Aq = 1.f, Bq = 0.f;
#pragma unroll
        for (int s = 0; s < 16; ++s) { const int tt = dir ? 15 - s : s; const float a = __expf(av[dir][tt]); av[dir][tt] = a; Bq = a * Bq + bv[dir][tt]; Aq *= a; }
        AG[((tq * 2 + dir) * 2 + 0) * 64 + j] = Aq; AG[((tq * 2 + dir) * 2 + 1) * 64 + j] = Bq; }
    __syncthreads();
    float hs[16];
#pragma unroll
    for (int dir = 0; dir < 2; ++dir) {
        float h = ((const float*)(p.ws + R_CR))[(size_t)((dir * 2 + b) * NCHK + c) * W + ch];
        for (int s = 0; s < 7; ++s) { const int q = dir ? 7 - s : s; const bool use = dir ? (q > tq) : (q < tq);
            const float a = AG[((q * 2 + dir) * 2 + 0) * 64 + j], bq = AG[((q * 2 + dir) * 2 + 1) * 64 + j]; if (use) h = a * h + bq; }
#pragma unroll
        for (int s = 0; s < 16; ++s) { const int tt = dir ? 15 - s : s; h = av[dir][tt] * h + bv[dir][tt]; if (dir == 0) hs[tt] = h; else hs[tt] += h; }
    }
#pragma unroll
    for (int tt = 0; tt < 16; ++tt) { const int i = 16 * tq + tt; const bool valid = (c * 128 + i - 112) >= 0;
        const float ga = bf2f(P[ro[tt] * NMIX + 512 + ch]);
        Z[ro[tt] * D + ch] = (bf16_t)(valid ? f2bf(hs[tt] * gelu_tanh(ga)) : 0u); }
}

__device__ __forceinline__ void conv3_16(const bf16_t* P, const float* cw, const float* cbias, int b, int t0, int col, float (&out)[16]) {
    const int cc = col - 1024; const float w0 = cw[cc], w1 = cw[1536 + cc], w2 = cw[3072 + cc], bb = cbias[cc];
    float xv[18];
#pragma unroll
    for (int q = 0; q < 18; ++q) { const int t = t0 - 1 + q; xv[q] = (t >= 0 && t < T) ? bf2f(P[(size_t)row_of(b, t) * NMIX + col]) : 0.f; }
#pragma unroll
    for (int tt = 0; tt < 16; ++tt) out[tt] = bb + w0 * xv[tt] + w1 * xv[tt + 1] + w2 * xv[tt + 2];
}

__device__ __forceinline__ void hy_s1_item(CParams& p, int layer, int item) {
    const int cidx = item >> 3, cgp = item & 7, b = cidx / NCHK, c = cidx % NCHK;
    const int tid = opaque_tid(), j = tid & 63, tq = tid >> 6, ch = cgp * 64 + j;
    const int t0 = c * 128 + 16 * tq - 112;
    if (t0 < 0) return;
    const bf16_t* P = (const bf16_t*)(p.ws + R_PMIX);
    const float* cw = p.in[12] + layer * 3 * 1536; const float* cbias = p.in[13] + layer * 1536;
    float x1[16], vv[16];
    conv3_16(P, cw, cbias, b, t0, 1024 + 512 + ch, x1); conv3_16(P, cw, cbias, b, t0, 1024 + 1024 + ch, vv);
    bf16_t* UT = (bf16_t*)(p.ws + R_UT) + ((size_t)ch * 2 + b) * TF + (t0 + FOFF);
    u32x4 wa, wb;
    wa.x = pk2(x1[0] * vv[0], x1[1] * vv[1]); wa.y = pk2(x1[2] * vv[2], x1[3] * vv[3]); wa.z = pk2(x1[4] * vv[4], x1[5] * vv[5]); wa.w = pk2(x1[6] * vv[6], x1[7] * vv[7]);
    wb.x = pk2(x1[8] * vv[8], x1[9] * vv[9]); wb.y = pk2(x1[10] * vv[10], x1[11] * vv[11]); wb.z = pk2(x1[12] * vv[12], x1[13] * vv[13]); wb.w = pk2(x1[14] * vv[14], x1[15] * vv[15]);
    *(u32x4*)UT = wa; *(u32x4*)(UT + 8) = wb;
}

__device__ __forceinline__ void hy_s3_item(CParams& p, int layer, int item) {
    const int cidx = item >> 3, cgp = item & 7, b = cidx / NCHK, c = cidx % NCHK;
    const int tid = opaque_tid(), j = tid & 63, tq = tid >> 6, ch = cgp * 64 + j;
    const int t0 = c * 128 + 16 * tq - 112;
    bf16_t* Z = (bf16_t*)(p.ws + OFF_Z);
    if (t0 < 0) {
#pragma unroll
        for (int tt = 0; tt < 16; ++tt) Z[(size_t)row_bci(b, c, 16 * tq + tt) * D + 512 + ch] = 0;
        return; }
    const bf16_t* P = (const bf16_t*)(p.ws + R_PMIX);
    const float* cw = p.in[12] + layer * 3 * 1536; const float* cbias = p.in[13] + layer * 1536;
    float x0[16];
    conv3_16(P, cw, cbias, b, t0, 1024 + ch, x0);
    const bf16_t* YT = (const bf16_t*)(p.ws + R_YT) + ((size_t)ch * 2 + b) * TF + (t0 + FOFF);
    const u32x4 ya = *(const u32x4*)YT, yb = *(const u32x4*)(YT + 8);
#pragma unroll
    for (int tt = 0; tt < 16; ++tt) { const unsigned wv = (tt < 8) ? ya[tt >> 1] : yb[(tt - 8) >> 1];
        const float y = (tt & 1) ? __uint_as_float(wv & 0xffff0000u) : __uint_as_float(wv << 16);
        Z[(size_t)row_bci(b, c, 16 * tq + tt) * D + 512 + ch] = (bf16_t)f2bf(x0[tt] * y); }
}

__device__ __forceinline__ bf16x8 toep_frag(const LAS unsigned* G32, int e) {
    const int d = e >> 1; const unsigned sh = (unsigned)(e & 1) * 16u;
    const unsigned w0 = G32[d], w1 = G32[d + 1], w2 = G32[d + 2], w3 = G32[d + 3], w4 = G32[d + 4];
    u32x4 r; r.x = __builtin_amdgcn_alignbit(w1, w0, sh); r.y = __builtin_amdgcn_alignbit(w2, w1, sh); r.z = __builtin_amdgcn_alignbit(w3, w2, sh); r.w = __builtin_amdgcn_alignbit(w4, w3, sh);
    return __builtin_bit_cast(bf16x8, r);
}

__device__ __forceinline__ bf16x8 toep_frag2(const LAS unsigned* q, unsigned sh) {
    const unsigned w0 = q[0], w1 = q[1], w2 = q[2], w3 = q[3], w4 = q[4];
    u32x4 r; r.x = __builtin_amdgcn_alignbit(w1, w0, sh); r.y = __builtin_amdgcn_alignbit(w2, w1, sh); r.z = __builtin_amdgcn_alignbit(w3, w2, sh); r.w = __builtin_amdgcn_alignbit(w4, w3, sh);
    return __builtin_bit_cast(bf16x8, r);
}

__device__ __forceinline__ void hy_conv_item(CParams& p, int layer, int ch, LAS unsigned char* lds) {
    LAS bf16_t* GRl = (LAS bf16_t*)lds; LAS bf16_t* UL = GRl + GRN; LAS float* PART = (LAS float*)(lds + GRN * 2 + 2 * UBT * 2);
    const int tid = opaque_tid(), lane = tid & 63, wave = tid >> 6, r = lane & 15, h = lane >> 4;
    const bf16_t* GRg = (const bf16_t*)(p.ws + R_GR) + (size_t)ch * GRN;
    const bf16_t* UTg = (const bf16_t*)(p.ws + R_UT) + (size_t)ch * 2 * TF;
    bf16_t* YTg = (bf16_t*)(p.ws + R_YT) + (size_t)ch * 2 * TF;
    const float bias = p.in[20][layer * W + ch];
    __syncthreads();
    for (int q = tid; q < GRN / 8; q += 512) { u32x4 v = *(const u32x4*)(GRg + q * 8);
        if (q < 254 || q >= 2306) v = (u32x4){0u, 0u, 0u, 0u}; else if (q == 254) v.x &= 0xffff0000u;
        *(LAS u32x4*)(GRl + q * 8) = v; }
    for (int q = tid; q < 2 * (TF / 8); q += 512) { const int bt = q / (TF / 8), f0 = (q % (TF / 8)) * 8;
        u32x4 v = (u32x4){0u, 0u, 0u, 0u}; if (f0 >= FOFF) v = *(const u32x4*)(UTg + (size_t)bt * TF + f0);
        *(LAS u32x4*)(UL + bt * UBT + ((f0 >> 7) + 15) * UBLK + (f0 & 127)) = v; }
    for (int q = tid; q < 2 * 30 * 17; q += 512) { const int bt = q / 510, rem = q % 510, blk = rem / 17, part = rem % 17; const int bi = blk < 15 ? blk : 65 + blk;
        *(LAS u32x4*)(UL + bt * UBT + bi * UBLK + part * 8) = (u32x4){0u, 0u, 0u, 0u}; }
    __syncthreads();
    const LAS unsigned* G32 = (const LAS unsigned*)GRl;
    { const int bt = wave >> 2, I0 = 1 + 16 * (wave & 3);
      f32x4 acc[8];
#pragma unroll
      for (int mi = 0; mi < 8; ++mi) acc[mi] = (f32x4){0.f, 0.f, 0.f, 0.f};
      const LAS bf16_t* ub = UL + bt * UBT + (I0 + r + 15) * UBLK + 8 * h;
      const int x0 = 8 * h - r + GROFF - 112;
      const unsigned sh = (unsigned)(x0 & 1) * 16u;
      const LAS unsigned* gq = G32 + (x0 >> 1) - 64 * (I0 + 15);
      const LAS bf16_t* uq = ub - (I0 + 15) * UBLK;
      bf16x8 R[16];
#pragma unroll
      for (int mm = 0; mm < 6; ++mm) R[(mm - 7) & 15] = toep_frag2(gq + 8 * mm, sh);
#define HY_STEP(PAR) { \
          _Pragma("unroll") for (int mm = 6; mm < 14; ++mm) R[(mm - 7 + 8 * (PAR)) & 15] = toep_frag2(gq + 8 * mm, sh); \
          _Pragma("unroll") for (int ks = 0; ks < 4; ++ks) { const bf16x8 B = *(const LAS bf16x8*)(uq + 32 * ks); \
              _Pragma("unroll") for (int mi = 0; mi < 8; ++mi) acc[mi] = __builtin_amdgcn_mfma_f32_16x16x32_bf16(R[(2 * ks - mi + 8 * (PAR)) & 15], B, acc[mi], 0, 0, 0); } \
          gq += 64; uq += UBLK; }
      for (int sp = 0; sp < 40; ++sp) { HY_STEP(0) HY_STEP(1) }
#undef HY_STEP
      const int I = I0 + r;
#pragma unroll
      for (int mi = 0; mi < 8; ++mi) { const int i = 16 * mi + 4 * h; const int f = 128 * I + i;
          const LAS bf16_t* up = UL + bt * UBT + (I + 15) * UBLK + i;
          u32x2 w; w.x = pk2(acc[mi][0] + bias * bf2f(up[0]), acc[mi][1] + bias * bf2f(up[1])); w.y = pk2(acc[mi][2] + bias * bf2f(up[2]), acc[mi][3] + bias * bf2f(up[3]));
          *(u32x2*)(YTg + (size_t)bt * TF + f) = w; }
    }
    if (layer == 0) { f32x4 am[8];
#pragma unroll
      for (int mi = 0; mi < 8; ++mi) am[mi] = (f32x4){0.f, 0.f, 0.f, 0.f};
      const int Lb = -64 + 8 * wave, Le = Lb + 8 + (wave == 7 ? 1 : 0);
      const int x0 = 8 * h - r + GROFF - 112; const unsigned sh = (unsigned)(x0 & 1) * 16u;
      for (int L = Lb; L < Le; ++L) {
          bf16x8 A[14];
          const LAS unsigned* gq = G32 + (x0 >> 1) - 64 * L;
#pragma unroll
          for (int mm = 0; mm < 14; ++mm) A[mm] = toep_frag2(gq + 8 * mm, sh);
#pragma unroll
          for (int ks = 0; ks < 4; ++ks) { const bf16x8 B = *(const LAS bf16x8*)(UL + (r & 1) * UBT + (15 - L) * UBLK + 32 * ks + 8 * h);
#pragma unroll
              for (int mi = 0; mi < 8; ++mi) am[mi] = __builtin_amdgcn_mfma_f32_16x16x32_bf16(A[2 * ks - mi + 7], B, am[mi], 0, 0, 0); }
      }
      if (r < 2) {
#pragma unroll
          for (int mi = 0; mi < 8; ++mi)
#pragma unroll
              for (int q = 0; q < 4; ++q) PART[(wave * 2 + r) * 128 + 16 * mi + 4 * h + q] = am[mi][q]; }
    }
    __syncthreads();
    if (layer == 0 && tid < 32) { const int bt = tid >> 4, i = 112 + (tid & 15); float s = 0.f;
#pragma unroll
        for (int w8 = 0; w8 < 8; ++w8) s += PART[(w8 * 2 + bt) * 128 + i];
        const float uu = bf2f(UL[bt * UBT + 15 * UBLK + i]); YTg[(size_t)bt * TF + i] = (bf16_t)f2bf(s + bias * uu); }
}

__device__ __forceinline__ void gla_decode(int w, int& grp, int& c) { if (w < 512) { grp = w >> 6; c = 1 + (w & 63); } else { grp = w - 512; c = 0; } }

__device__ __forceinline__ unsigned cvt_pk_bf16(float lo, float hi) { return pk2(lo, hi); }
__device__ __forceinline__ bf16x8 pack8(const f32x4 a, const f32x4 b) { u32x4 w; w.x = cvt_pk_bf16(a[0], a[1]); w.y = cvt_pk_bf16(a[2], a[3]); w.z = cvt_pk_bf16(b[0], b[1]); w.w = cvt_pk_bf16(b[2], b[3]); return __builtin_bit_cast(bf16x8, w); }
constexpr int GL_QS = 136, GL_TS = 40;
constexpr int GL_QT = 0, GL_KT = 32 * GL_QS * 2, GL_KHT = 2 * 32 * GL_QS * 2, GL_VT = GL_KHT + 128 * GL_TS * 2, GL_GS = GL_VT + 128 * GL_TS * 2, GL_HEAD = GL_GS + 512;

__device__ __forceinline__ float scan32_add(float v) {
    v += __int_as_float(__builtin_amdgcn_update_dpp(0, __float_as_int(v), 0x111, 0xf, 0xf, false));
    v += __int_as_float(__builtin_amdgcn_update_dpp(0, __float_as_int(v), 0x112, 0xf, 0xf, false));
    v += __int_as_float(__builtin_amdgcn_update_dpp(0, __float_as_int(v), 0x114, 0xf, 0xf, false));
    v += __int_as_float(__builtin_amdgcn_update_dpp(0, __float_as_int(v), 0x118, 0xf, 0xf, false));
    v += __int_as_float(__builtin_amdgcn_update_dpp(0, __float_as_int(v), 0x142, 0xa, 0xf, false));
    return v;
}
template <bool PH3>
__device__ __forceinline__ void gla_item(CParams& p, int layer, int w, LAS unsigned char* lds) {
    int grp, c; gla_decode(w, grp, c);
    const int br = grp >> 2, dir = (grp >> 1) & 1, b = grp & 1, item = grp * NCHK + c;
    const bool incl = !(br == 0 && dir == 1);
    const int tid = opaque_tid(), lane = tid & 63, wave = tid >> 6, hd = wave >> 1, vh = wave & 1, r = lane & 15, h = lane >> 4;
    LAS unsigned char* hb = lds + hd * GL_HEAD;
    const bf16_t* P = (const bf16_t*)(p.ws + R_PMIX);
    const f32x2* RT = (const f32x2*)(p.ws + OFF_ROPE);
    bf16_t* U = (bf16_t*)(p.ws + R_U) + (size_t)item * 65536 + (size_t)(hd * 128 + 4 * h) * 128 + 64 * vh + r;
    f32x4 S[8][4];
#pragma unroll
    for (int dt = 0; dt < 8; ++dt)
#pragma unroll
        for (int vt = 0; vt < 4; ++vt) {
            if (PH3) {
#pragma unroll
                for (int q = 0; q < 4; ++q) S[dt][vt][q] = bf2f(U[(16 * dt + q) * 128 + 16 * vt]);
            } else S[dt][vt] = (f32x4){0.f, 0.f, 0.f, 0.f}; }
    const int fcol = dir ? 5632 : 5120;
    bf16_t* Og = (bf16_t*)(p.ws + R_O) + (size_t)(br * 2 + dir) * MP * W;
    const int nsb = (c == 0) ? 1 : 4;
    for (int sbi = 0; sbi < nsb; ++sbi) {
        const int sb = (c == 0) ? 3 : (dir ? 3 - sbi : sbi);
        __syncthreads();
        {
            const int ip = lane & 31, hw = (lane >> 5) + 2 * wave;
            const int i = sb * 32 + (dir ? 31 - ip : ip), t = c * 128 + i - 112; const bool valid = t >= 0;
            const bf16_t* prow = P + (size_t)row_bci(b, c, i) * NMIX;
#pragma unroll 2
            for (int itc = 0; itc < 4; ++itc) {
                const int d0 = 8 * (hw + 16 * itc), shd = d0 >> 7, sdl = d0 & 127;
                LAS unsigned char* hs = lds + shd * GL_HEAD;
                float q[8], k[8], v[8], l[8];
                if (br == 0) {
                    const u32x4 kr = *(const u32x4*)(prow + 3072 + d0), kp = *(const u32x4*)(prow + 3072 + (d0 ^ 64)), vr = *(const u32x4*)(prow + 3584 + d0);
                    u32x4 qr = (u32x4){0u, 0u, 0u, 0u}, qp = (u32x4){0u, 0u, 0u, 0u};
                    if (PH3) { qr = *(const u32x4*)(prow + 2560 + d0); qp = *(const u32x4*)(prow + 2560 + (d0 ^ 64)); }
                    const f32x4* rt = (const f32x4*)(RT + (size_t)(valid ? t : 0) * 64 + (sdl & 63));
                    const f32x4 c0 = rt[0], c1 = rt[1], c2 = rt[2], c3 = rt[3];
                    const float cs[16] = {c0[0], c0[1], c0[2], c0[3], c1[0], c1[1], c1[2], c1[3], c2[0], c2[1], c2[2], c2[3], c3[0], c3[1], c3[2], c3[3]};
                    const float sgn = (sdl < 64) ? -1.f : 1.f; const float lg = log1pf(-exp2f(-5.0f - (float)shd));
#pragma unroll
                    for (int e = 0; e < 8; ++e) { const unsigned wkr = kr[e >> 1], wkp = kp[e >> 1], wvr = vr[e >> 1], wqr = qr[e >> 1], wqp = qp[e >> 1];
                        const float fkr = (e & 1) ? __uint_as_float(wkr & 0xffff0000u) : __uint_as_float(wkr << 16), fkp = (e & 1) ? __uint_as_float(wkp & 0xffff0000u) : __uint_as_float(wkp << 16);
                        const float fqr = (e & 1) ? __uint_as_float(wqr & 0xffff0000u) : __uint_as_float(wqr << 16), fqp = (e & 1) ? __uint_as_float(wqp & 0xffff0000u) : __uint_as_float(wqp << 16);
                        k[e] = (fkr * cs[2 * e] + sgn * fkp * cs[2 * e + 1]) * 0.08838834764831845f; q[e] = fqr * cs[2 * e] + sgn * fqp * cs[2 * e + 1];
                        v[e] = (e & 1) ? __uint_as_float(wvr & 0xffff0000u) : __uint_as_float(wvr << 16); l[e] = lg; }
                } else {
                    const u32x4 fr = *(const u32x4*)(prow + fcol + d0), vr = *(const u32x4*)(prow + 6144 + d0);
                    u32x4 qr = (u32x4){0u, 0u, 0u, 0u}; if (PH3) qr = *(const u32x4*)(prow + 4608 + d0);
                    const f32x4 la = *(const f32x4*)((const float*)(p.ws + OFF_LBT) + d0), lb4 = *(const f32x4*)((const float*)(p.ws + OFF_LBT) + d0 + 4);
#pragma unroll
                    for (int e = 0; e < 8; ++e) { const unsigned wfr = fr[e >> 1], wvr = vr[e >> 1], wqr = qr[e >> 1];
                        const float ffr = (e & 1) ? __uint_as_float(wfr & 0xffff0000u) : __uint_as_float(wfr << 16), fqr = (e & 1) ? __uint_as_float(wqr & 0xffff0000u) : __uint_as_float(wqr << 16);
                        const float lbv = e < 4 ? la[e & 3] : lb4[e & 3];
                        const float f = lbv + (1.0f - lbv) * sigm(ffr); l[e] = __logf(f); k[e] = 1.0f - f; q[e] = fqr * sigm(fqr);
                        v[e] = (e & 1) ? __uint_as_float(wvr & 0xffff0000u) : __uint_as_float(wvr << 16); }
                }
                if (!valid) {
#pragma unroll
                    for (int e = 0; e < 8; ++e) { q[e] = 0.f; k[e] = 0.f; v[e] = 0.f; l[e] = 0.f; } }
                float eb[8], enb[8];
                if (br == 0) {
                    const float l0 = scan32_add(l[0]); const float a0 = __expf(l0), b0 = __expf(fminf(-l0, 80.0f));
#pragma unroll
                    for (int e = 0; e < 8; ++e) { l[e] = l0; eb[e] = a0; enb[e] = b0; }
                } else {
#pragma unroll
                    for (int e = 0; e < 8; ++e) { l[e] = scan32_add(l[e]); enb[e] = __expf(fminf(-l[e], 80.0f)); eb[e] = PH3 ? __expf(l[e]) : 0.f; }
                }
                float kt[8];
#pragma unroll
                for (int e = 0; e < 8; ++e) kt[e] = k[e] * enb[e];
                LAS bf16_t* sKHT = (LAS bf16_t*)(hs + GL_KHT); LAS bf16_t* sVT = (LAS bf16_t*)(hs + GL_VT);
                if (PH3) { u32x4 wq, wk;
                    wq.x = cvt_pk_bf16(q[0] * eb[0], q[1] * eb[1]); wq.y = cvt_pk_bf16(q[2] * eb[2], q[3] * eb[3]);
                    wq.z = cvt_pk_bf16(q[4] * eb[4], q[5] * eb[5]); wq.w = cvt_pk_bf16(q[6] * eb[6], q[7] * eb[7]);
                    wk.x = cvt_pk_bf16(kt[0], kt[1]); wk.y = cvt_pk_bf16(kt[2], kt[3]); wk.z = cvt_pk_bf16(kt[4], kt[5]); wk.w = cvt_pk_bf16(kt[6], kt[7]);
                    *(LAS u32x4*)((LAS bf16_t*)(hs + GL_QT) + ip * GL_QS + sdl) = wq; *(LAS u32x4*)((LAS bf16_t*)(hs + GL_KT) + ip * GL_QS + sdl) = wk; }
#pragma unroll
                for (int e = 0; e < 8; ++e) { sKHT[(sdl + e) * GL_TS + ip] = (bf16_t)f2bf(kt[e]); sVT[(sdl + e) * GL_TS + ip] = (bf16_t)f2bf(v[e]); }
                if (ip == 31) { LAS float* sGS = (LAS float*)(hs + GL_GS); LAS float* LT = (LAS float*)(lds + 4 * GL_HEAD);
#pragma unroll
                    for (int e = 0; e < 8; ++e) { sGS[sdl + e] = __expf(l[e]); LT[d0 + e] = (sbi == 0 ? 0.f : LT[d0 + e]) + l[e]; } }
            }
        }
        __syncthreads();
        const LAS bf16_t* QT = (const LAS bf16_t*)(hb + GL_QT); const LAS bf16_t* KT = (const LAS bf16_t*)(hb + GL_KT);
        const LAS bf16_t* KHT = (const LAS bf16_t*)(hb + GL_KHT); const LAS bf16_t* VT = (const LAS bf16_t*)(hb + GL_VT); const LAS float* GS = (const LAS float*)(hb + GL_GS);
        if (PH3) {
            f32x4 X[2][2];
#pragma unroll
            for (int a = 0; a < 2; ++a)
#pragma unroll
                for (int bq = 0; bq < 2; ++bq) X[a][bq] = (f32x4){0.f, 0.f, 0.f, 0.f};
#pragma unroll
            for (int kk = 0; kk < 4; ++kk) { bf16x8 aK[2], bQ[2];
#pragma unroll
                for (int t2 = 0; t2 < 2; ++t2) { aK[t2] = *(const LAS bf16x8*)(KT + (16 * t2 + r) * GL_QS + 32 * kk + 8 * h); bQ[t2] = *(const LAS bf16x8*)(QT + (16 * t2 + r) * GL_QS + 32 * kk + 8 * h); }
#pragma unroll
                for (int jt = 0; jt < 2; ++jt)
#pragma unroll
                    for (int it = 0; it < 2; ++it) X[jt][it] = __builtin_amdgcn_mfma_f32_16x16x32_bf16(aK[jt], bQ[it], X[jt][it], 0, 0, 0); }
            bf16x8 PA[2];
#pragma unroll
            for (int it = 0; it < 2; ++it) { f32x4 lo, hi; const int ipx = 16 * it + r;
#pragma unroll
                for (int q = 0; q < 4; ++q) { const int j0 = 4 * h + q, j1 = 16 + 4 * h + q;
                    lo[q] = (incl ? (j0 <= ipx) : (j0 < ipx)) ? X[0][it][q] : 0.f; hi[q] = (incl ? (j1 <= ipx) : (j1 < ipx)) ? X[1][it][q] : 0.f; }
                PA[it] = pack8(lo, hi); }
            f32x4 O[2][4];
#pragma unroll
            for (int vt = 0; vt < 4; ++vt) { const LAS bf16_t* vp = VT + (64 * vh + 16 * vt + r) * GL_TS;
                const u32x2 lo = *(const LAS u32x2*)(vp + 4 * h), hi = *(const LAS u32x2*)(vp + 16 + 4 * h);
                const bf16x8 BV = __builtin_bit_cast(bf16x8, ((u32x4){lo.x, lo.y, hi.x, hi.y}));
#pragma unroll
                for (int it = 0; it < 2; ++it) O[it][vt] = __builtin_amdgcn_mfma_f32_16x16x32_bf16(PA[it], BV, (f32x4){0.f, 0.f, 0.f, 0.f}, 0, 0, 0); }
#pragma unroll
            for (int kk = 0; kk < 4; ++kk) { bf16x8 aQ[2];
#pragma unroll
                for (int it = 0; it < 2; ++it) { const LAS bf16_t* qp = QT + (16 * it + r) * GL_QS + 32 * kk;
                    const u32x2 lo = *(const LAS u32x2*)(qp + 4 * h), hi = *(const LAS u32x2*)(qp + 16 + 4 * h);
                    aQ[it] = __builtin_bit_cast(bf16x8, ((u32x4){lo.x, lo.y, hi.x, hi.y})); }
#pragma unroll
                for (int vt = 0; vt < 4; ++vt) { const bf16x8 BS = pack8(S[2 * kk][vt], S[2 * kk + 1][vt]);
#pragma unroll
                    for (int it = 0; it < 2; ++it) O[it][vt] = __builtin_amdgcn_mfma_f32_16x16x32_bf16(aQ[it], BS, O[it][vt], 0, 0, 0); } }
#pragma unroll
            for (int it = 0; it < 2; ++it)
#pragma unroll
                for (int q = 0; q < 4; ++q) { const int ipx = 16 * it + 4 * h + q, i = sb * 32 + (dir ? 31 - ipx : ipx);
                    if ((c * 128 + i - 112) >= 0) { bf16_t* op = Og + (size_t)row_bci(b, c, i) * W + hd * 128 + 64 * vh + r;
#pragma unroll
                        for (int vt = 0; vt < 4; ++vt) op[16 * vt] = (bf16_t)f2bf(O[it][vt][q]); } }
        }
        {
            bf16x8 bV[4];
#pragma unroll
            for (int vt = 0; vt < 4; ++vt) bV[vt] = *(const LAS bf16x8*)(VT + (64 * vh + 16 * vt + r) * GL_TS + 8 * h);
#pragma unroll
            for (int dt = 0; dt < 8; ++dt) { const f32x4 g4 = *(const LAS f32x4*)(GS + 16 * dt + 4 * h); const bf16x8 aKH = *(const LAS bf16x8*)(KHT + (16 * dt + r) * GL_TS + 8 * h);
#pragma unroll
                for (int vt = 0; vt < 4; ++vt) S[dt][vt] = __builtin_amdgcn_mfma_f32_16x16x32_bf16(aKH, bV[vt], S[dt][vt], 0, 0, 0) * g4; }
        }
    }
    if (!PH3) {
#pragma unroll
        for (int dt = 0; dt < 8; ++dt)
#pragma unroll
            for (int vt = 0; vt < 4; ++vt)
#pragma unroll
                for (int q = 0; q < 4; ++q) U[(16 * dt + q) * 128 + 16 * vt] = (bf16_t)f2bf(S[dt][vt][q]);
        __syncthreads();
        ((float*)(p.ws + R_GG))[(size_t)item * 512 + tid] = __expf(((const LAS float*)(lds + 4 * GL_HEAD))[tid]);
    }
}

__device__ __forceinline__ void gla_carry(CParams& p) {
    const int gidx = blockIdx.x * 512 + opaque_tid();
    if (gidx >= 8 * 16384) return;
    const int grp = gidx >> 14, e4 = gidx & 16383, dir = (grp >> 1) & 1, hdd = (e4 * 4) >> 7;
    bf16_t* U = (bf16_t*)(p.ws + R_U) + (size_t)grp * NCHK * 65536 + e4 * 4; const float* GG = (const float*)(p.ws + R_GG) + (size_t)grp * NCHK * 512 + hdd;
    f32x4 S = (f32x4){0.f, 0.f, 0.f, 0.f};
    for (int s0 = 0; s0 < NCHK; s0 += 5) {
        u32x2 u[5]; float g[5];
#pragma unroll
        for (int q = 0; q < 5; ++q) { const int c = dir ? NCHK - 1 - (s0 + q) : (s0 + q); u[q] = *(const u32x2*)(U + (size_t)c * 65536); g[q] = GG[(size_t)c * 512]; }
#pragma unroll
        for (int q = 0; q < 5; ++q) { const int c = dir ? NCHK - 1 - (s0 + q) : (s0 + q);
            u32x2 w; w.x = pk2(S[0], S[1]); w.y = pk2(S[2], S[3]); *(u32x2*)(U + (size_t)c * 65536) = w;
            const f32x4 uv = (f32x4){__uint_as_float(u[q].x << 16), __uint_as_float(u[q].x & 0xffff0000u), __uint_as_float(u[q].y << 16), __uint_as_float(u[q].y & 0xffff0000u)};
            S = S * g[q] + uv; }
    }
}

__device__ __forceinline__ void gla_s4(CParams& p) {
    const int tid0 = opaque_tid(); const int lane = tid0 & 63, gw = blockIdx.x * 8 + (tid0 >> 6), NW = gridDim.x * 8;
    const bf16_t* P = (const bf16_t*)(p.ws + R_PMIX); const bf16_t* O = (const bf16_t*)(p.ws + R_O); bf16_t* Z = (bf16_t*)(p.ws + OFF_Z);
    for (int it = gw; it < MP * 2; it += NW) { const int row = it >> 1, br = it & 1;
        bf16_t* zp = Z + (size_t)row * D + 1024 + br * W + lane * 8;
        if (row >= MX && ((row - MX) & 127) < 112) { *(u32x4*)zp = (u32x4){0u, 0u, 0u, 0u}; continue; }
        const u32x4 of = *(const u32x4*)(O + ((size_t)(br * 2 + 0) * MP + row) * W + lane * 8), ob = *(const u32x4*)(O + ((size_t)(br * 2 + 1) * MP + row) * W + lane * 8);
        const u32x4 gv = *(const u32x4*)(P + (size_t)row * NMIX + (br ? 6656 : 4096) + lane * 8);
        float o[8], g[8];
#pragma unroll
        for (int q = 0; q < 4; ++q) { o[2 * q] = __uint_as_float(of[q] << 16) + __uint_as_float(ob[q] << 16); o[2 * q + 1] = __uint_as_float(of[q] & 0xffff0000u) + __uint_as_float(ob[q] & 0xffff0000u);
            g[2 * q] = __uint_as_float(gv[q] << 16); g[2 * q + 1] = __uint_as_float(gv[q] & 0xffff0000u); }
        float s = 0.f;
#pragma unroll
        for (int q = 0; q < 8; ++q) s += o[q];
        s += __shfl_xor(s, 1); s += __shfl_xor(s, 2); s += __shfl_xor(s, 4); s += __shfl_xor(s, 8);
        const float mu = br ? 0.f : s * (1.0f / 128.0f);
        float s2 = 0.f;
#pragma unroll
        for (int q = 0; q < 8; ++q) { o[q] -= mu; s2 += o[q] * o[q]; }
        s2 += __shfl_xor(s2, 1); s2 += __shfl_xor(s2, 2); s2 += __shfl_xor(s2, 4); s2 += __shfl_xor(s2, 8);
        const float rs = 1.0f / sqrtf(s2 * (1.0f / 128.0f) + EPS);
        u32x4 w;
#pragma unroll
        for (int q = 0; q < 4; ++q) w[q] = pk2(o[2 * q] * rs * siluf(g[2 * q]), o[2 * q + 1] * rs * siluf(g[2 * q + 1]));
        *(u32x4*)zp = w; }
}


__device__ __forceinline__ void skinny_acc(const bf16_t* A, int lda, const bf16_t* Wrow, int ldw, int k_begin, int nk, int r, int h, f32x4 (&acc)[2]) {
    const bf16_t* a0 = A + (size_t)(MX + 112 + r) * lda + 8 * h + k_begin;
    const bf16_t* a1 = A + (size_t)(MX + 128 + 112 + r) * lda + 8 * h + k_begin;
    const bf16_t* bp = Wrow + (size_t)r * ldw + 8 * h + k_begin;
#pragma unroll 8
    for (int ks = 0; ks < nk; ++ks) { const bf16x8 x0 = *(const bf16x8*)(a0 + 32 * ks), x1 = *(const bf16x8*)(a1 + 32 * ks), bb = *(const bf16x8*)(bp + 32 * ks);
        acc[0] = __builtin_amdgcn_mfma_f32_16x16x32_bf16(x0, bb, acc[0], 0, 0, 0); acc[1] = __builtin_amdgcn_mfma_f32_16x16x32_bf16(x1, bb, acc[1], 0, 0, 0); }
}
#define SK_HEAD const int tid = opaque_tid(), lane = tid & 63, wave = tid >> 6, r = lane & 15, h = lane >> 4; LAS float* part = (LAS float*)lds; \
    const int e_mt = tid >> 8, e_q = (tid >> 6) & 3, e_h = (tid & 63) >> 4, e_r = tid & 15; const size_t e_row = (size_t)(MX + 128 * e_mt + 112 + 4 * e_h + e_q);
__device__ __forceinline__ void sk_put(LAS float* part, int wave, int lane, const f32x4 (&acc)[2]) {
#pragma unroll
    for (int mt = 0; mt < 2; ++mt)
#pragma unroll
        for (int q = 0; q < 4; ++q) part[wave * 512 + (mt * 4 + q) * 64 + lane] = acc[mt][q];
}
__device__ __forceinline__ float sk_sum8(const LAS float* part, int tid) { float s = 0.f;
#pragma unroll
    for (int w8 = 0; w8 < 8; ++w8) s += part[w8 * 512 + tid];
    return s; }
__device__ __forceinline__ void skinny_in(CParams& p, int mode, LAS unsigned char* lds) {
    SK_HEAD
    const bf16_t* NB = (const bf16_t*)(p.ws + OFF_NB); const bf16_t* WIN = (const bf16_t*)(p.ws + OFF_WIN) + (size_t)(mode ? NMIX : 0) * D;
    const int ntile = mode ? NGATE / 16 : NMIX / 16;
    for (int t0 = blockIdx.x; t0 < ntile; t0 += 2 * gridDim.x) { const int t1 = t0 + gridDim.x; const bool two = t1 < ntile; const int t1c = two ? t1 : t0;
        f32x4 aA[2] = {(f32x4){0.f, 0.f, 0.f, 0.f}, (f32x4){0.f, 0.f, 0.f, 0.f}}, aB[2] = {(f32x4){0.f, 0.f, 0.f, 0.f}, (f32x4){0.f, 0.f, 0.f, 0.f}};
        __syncthreads();
        { const int kb = wave * (D / 8);
          const bf16_t* a0 = NB + (size_t)(MX + 112 + r) * D + 8 * h + kb; const bf16_t* a1 = NB + (size_t)(MX + 128 + 112 + r) * D + 8 * h + kb;
          const bf16_t* b0 = WIN + (size_t)(t0 * 16 + r) * D + 8 * h + kb; const bf16_t* b1 = WIN + (size_t)(t1c * 16 + r) * D + 8 * h + kb;
#pragma unroll
          for (int ks = 0; ks < D / 256; ++ks) { const bf16x8 x0 = *(const bf16x8*)(a0 + 32 * ks), x1 = *(const bf16x8*)(a1 + 32 * ks), w0 = *(const bf16x8*)(b0 + 32 * ks), w1 = *(const bf16x8*)(b1 + 32 * ks);
              aA[0] = __builtin_amdgcn_mfma_f32_16x16x32_bf16(x0, w0, aA[0], 0, 0, 0); aA[1] = __builtin_amdgcn_mfma_f32_16x16x32_bf16(x1, w0, aA[1], 0, 0, 0);
              aB[0] = __builtin_amdgcn_mfma_f32_16x16x32_bf16(x0, w1, aB[0], 0, 0, 0); aB[1] = __builtin_amdgcn_mfma_f32_16x16x32_bf16(x1, w1, aB[1], 0, 0, 0); } }
        sk_put(part, wave, lane, aA); sk_put(part + 4096, wave, lane, aB);
        __syncthreads();
        const float sA = sk_sum8(part, tid), sB = sk_sum8(part + 4096, tid);
        if (mode) { bf16_t* G = (bf16_t*)(p.ws + R_G); G[e_row * NGATE + t0 * 16 + e_r] = (bf16_t)f2bf(sA); if (two) G[e_row * NGATE + t1 * 16 + e_r] = (bf16_t)f2bf(sB); }
        else { bf16_t* P = (bf16_t*)(p.ws + R_PMIX); P[e_row * NMIX + t0 * 16 + e_r] = (bf16_t)f2bf(sA); if (two) P[e_row * NMIX + t1 * 16 + e_r] = (bf16_t)f2bf(sB); } }
}
__device__ __forceinline__ void skinny_branch(CParams& p, LAS unsigned char* lds) {
    SK_HEAD
    const bf16_t* Z = (const bf16_t*)(p.ws + OFF_Z); const bf16_t* WBO = (const bf16_t*)(p.ws + OFF_WBO); const bf16_t* G = (const bf16_t*)(p.ws + R_G); bf16_t* MB = (bf16_t*)(p.ws + R_MB);
    const int z = wave >> 1, kh = wave & 1;
    for (int tile = blockIdx.x; tile < D / 16; tile += gridDim.x) { f32x4 acc[2] = {(f32x4){0.f, 0.f, 0.f, 0.f}, (f32x4){0.f, 0.f, 0.f, 0.f}};
        __syncthreads();
        skinny_acc(Z + z * W, D, WBO + (size_t)z * D * W + (size_t)tile * 16 * W, W, kh * (W / 2), W / 64, r, h, acc);
        sk_put(part, wave, lane, acc);
        __syncthreads();
        float tot = 0.f;
#pragma unroll
        for (int zz = 0; zz < 4; ++zz) tot += sigm(bf2f(G[e_row * NGATE + zz * D + tile * 16 + e_r])) * (part[(2 * zz) * 512 + tid] + part[(2 * zz + 1) * 512 + tid]);
        MB[e_row * D + tile * 16 + e_r] = (bf16_t)f2bf(tot); }
}
__device__ __forceinline__ void skinny_resid(CParams& p, const bf16_t* A, int lda, const bf16_t* Wt, int K, LAS unsigned char* lds) {
    SK_HEAD
    float* H = (float*)(p.ws + OFF_H);
    for (int tile = blockIdx.x; tile < D / 16; tile += gridDim.x) { f32x4 acc[2] = {(f32x4){0.f, 0.f, 0.f, 0.f}, (f32x4){0.f, 0.f, 0.f, 0.f}};
        __syncthreads();
        skinny_acc(A, lda, Wt + (size_t)tile * 16 * K, K, wave * (K / 8), K / 256, r, h, acc);
        sk_put(part, wave, lane, acc);
        __syncthreads();
        H[e_row * D + tile * 16 + e_r] += sk_sum8(part, tid); }
}
__device__ __forceinline__ void skinny_swiglu(CParams& p, LAS unsigned char* lds) {
    SK_HEAD
    const bf16_t* NB = (const bf16_t*)(p.ws + OFF_NB); const bf16_t* WGU = (const bf16_t*)(p.ws + OFF_WGU); bf16_t* FF = (bf16_t*)(p.ws + R_FF);
    for (int tile = blockIdx.x; tile < DFF / 16; tile += gridDim.x) { const int c0 = tile * 16, wr0 = 256 * (c0 >> 7) + (c0 & 127);
        f32x4 ag[2] = {(f32x4){0.f, 0.f, 0.f, 0.f}, (f32x4){0.f, 0.f, 0.f, 0.f}}, au[2] = {(f32x4){0.f, 0.f, 0.f, 0.f}, (f32x4){0.f, 0.f, 0.f, 0.f}};
        __syncthreads();
        skinny_acc(NB, D, WGU + (size_t)wr0 * D, D, wave * (D / 8), D / 256, r, h, ag); skinny_acc(NB, D, WGU + (size_t)(wr0 + 128) * D, D, wave * (D / 8), D / 256, r, h, au);
        sk_put(part, wave, lane, ag); sk_put(part + 4096, wave, lane, au);
        __syncthreads();
        const float g = sk_sum8(part, tid), u = sk_sum8(part + 4096, tid);
        FF[e_row * DFF + c0 + e_r] = (bf16_t)f2bf(siluf(g) * u); }
}


#define XB_TMO      128
#define XB_XCNT(j)  (256  + 64 * (j))
#define XB_XSUB(j)  (1280 + 64 * (j))
#define XB_XGEN(j)  (2304 + 64 * (j))
#define XB_TOP      3328
#define XB_TOPGEN   3392
#define XCD_BAR_WORDS 3456
#define XB_SPIN_CAP (1u << 22)
__device__ __forceinline__ unsigned xb_ld(unsigned* p)              { return __hip_atomic_load(p, __ATOMIC_RELAXED, __HIP_MEMORY_SCOPE_AGENT); }
__device__ __forceinline__ unsigned xb_add(unsigned* p, unsigned v) { return __hip_atomic_fetch_add(p, v, __ATOMIC_RELAXED, __HIP_MEMORY_SCOPE_AGENT); }
__device__ __forceinline__ unsigned xb_xcc_id() { return (unsigned)__builtin_amdgcn_s_getreg((3 << 11) | 20) & 0xFu; }
#define XB_SPIN(cond, bar) do { unsigned _sp = 0; while (cond) { __builtin_amdgcn_s_sleep(1); \
    if ((++_sp & 255u) == 0u) { if (xb_ld(&(bar)[XB_TMO])) break; if (_sp > XB_SPIN_CAP) { atomicAdd(&(bar)[XB_TMO], 1u); break; } } } } while (0)
struct XcdBarrier { unsigned* bar; unsigned x; volatile LAS unsigned* st; };
__device__ __forceinline__ XcdBarrier xcd_barrier_post(unsigned* bar, volatile LAS unsigned* st) {
    XcdBarrier b; b.bar = bar; b.x = xb_xcc_id(); b.st = st;
    if (threadIdx.x == 0) (void)xb_add(&bar[XB_XCNT(b.x)], 1u);
    return b;
}
__device__ __forceinline__ void xcd_barrier_complete(unsigned* bar, unsigned x, unsigned& nloc, unsigned& nx) {
    const unsigned G = gridDim.x * gridDim.y * gridDim.z;
    unsigned sum, cnt, mine, sp = 0u;
    for (;;) {
        sum = 0u; cnt = 0u; mine = 0u;
#pragma unroll
        for (unsigned j = 0; j < 16; ++j) { const unsigned c = xb_ld(&bar[XB_XCNT(j)]); sum += c; cnt += (c > 0u) ? 1u : 0u; mine = (j == x) ? c : mine; }
        if (sum == G) break;
        __builtin_amdgcn_s_sleep(1);
        if ((++sp & 255u) == 0u) { if (xb_ld(&bar[XB_TMO])) break; if (sp > XB_SPIN_CAP) { atomicAdd(&bar[XB_TMO], 1u); break; } }
    }
    nloc = mine > 0u ? mine : 1u; nx = cnt > 0u ? cnt : 1u;
}
__device__ __forceinline__ void xcd_barrier(const XcdBarrier& b) {
    asm volatile("s_waitcnt vmcnt(0)" ::: "memory");
    __syncthreads();
    if (threadIdx.x == 0) {
        unsigned* bar = b.bar;
        __builtin_amdgcn_s_waitcnt(0);
        unsigned nloc = b.st[0], nx = b.st[1];
        if (nloc == 0u) { xcd_barrier_complete(bar, b.x, nloc, nx); b.st[0] = nloc; b.st[1] = nx; }
        const unsigned old = xb_add(&bar[XB_XSUB(b.x)], 1u);
        const unsigned gen = old / nloc;
        if (old + 1u == (gen + 1u) * nloc) {
            __builtin_amdgcn_fence(__ATOMIC_RELEASE, "agent");
            asm volatile("s_waitcnt vmcnt(0)" ::: "memory");
            const unsigned og = xb_add(&bar[XB_TOP], 1u);
            const unsigned tg = og / nx;
            if (og + 1u == (tg + 1u) * nx) xb_add(&bar[XB_TOPGEN], 1u);
            else XB_SPIN(xb_ld(&bar[XB_TOPGEN]) == tg, bar);
            __builtin_amdgcn_fence(__ATOMIC_ACQUIRE, "agent");
            xb_add(&bar[XB_XGEN(b.x)], 1u);
            asm volatile("s_waitcnt vmcnt(0)" ::: "memory");
        } else {
            XB_SPIN(xb_ld(&bar[XB_XGEN(b.x)]) == gen, bar);
            __builtin_amdgcn_fence(__ATOMIC_ACQUIRE, "agent");
            asm volatile("s_waitcnt vmcnt(0)" ::: "memory");
        }
    }
    __syncthreads();
}

#ifndef WG_A
#define WG_A 4
#endif
#ifndef WG_N8
#define WG_N8 4
#endif
#ifndef PH_MASK
#define PH_MASK 0xFFFFFFF
#endif
#ifndef REP_MASK
#define REP_MASK 0
#endif
#define PH(n) for (int _r = 0, _n = 1 + ((p.rep >> (n)) & 1); _r < _n; ++_r) if (PH_MASK & (1 << (n)))
__device__ __forceinline__ CParams* kparams() { CParams* q = (CParams*)__builtin_amdgcn_kernarg_segment_ptr(); asm volatile("" : "+s"(q)); return q; }
#define p (*kparams())
__global__ void __launch_bounds__(512, 2) mega(Params p_unused) {
    extern __shared__ __attribute__((aligned(16))) unsigned char lds_raw[];
    LAS unsigned char* lds = (LAS unsigned char*)lds_raw;
    cg::grid_group grid = cg::this_grid();
    const int G = gridDim.x, bx = blockIdx.x;
    volatile LAS unsigned* xst = (volatile LAS unsigned*)(lds + 157680);
    if (threadIdx.x == 0) { xst[0] = 0u; xst[1] = 0u; }
    __syncthreads();
    const XcdBarrier xb = xcd_barrier_post((unsigned*)(p.ws + OFF_BAR), xst);
#pragma unroll 1
    for (int layer = 0; layer < 2; ++layer) {
        PH(0) phase_prep(p, layer, lds);
        if (layer == 0) grid.sync(); else xcd_barrier(xb);
        PH(1) { pg8::PlainSched S{MX / 256, NMIX / 256, G, bx, (const char*)(p.ws + OFF_NB), (const char*)(p.ws + OFF_WIN), (size_t)256 * D * 2, (size_t)256 * D * 2, WG_A};
          pg8::EpiBf16<0> E{(bf16_t*)(p.ws + R_PMIX), NMIX};
          pg8::gemm_phase(lds, D, D, D, S, E); }
        PH(18) skinny_in(p, 0, lds);
        xcd_barrier(xb);
        PH(2) for (int it = bx; it < 520; it += G) gla_item<false>(p, layer, it, lds);
        PH(3) for (int it = (G == 256 ? (bx ^ 128) : bx); it < 1040; it += G) lru_s1_item(p, layer, it, lds);
        PH(4) for (int it = (G == 256 ? (bx ^ 64) : bx); it < 1040; it += G) hy_s1_item(p, layer, it);
        xcd_barrier(xb);
        PH(5) for (int ch = bx; ch < W; ch += G) hy_conv_item(p, layer, ch, lds);
        PH(6) lru_carry(p);
        PH(6) gla_carry(p);
        xcd_barrier(xb);
        PH(7) for (int it = bx; it < 520; it += G) gla_item<true>(p, layer, it, lds);
        PH(8) for (int it = (G == 256 ? (bx ^ 128) : bx); it < 1040; it += G) lru_s3_item(p, it, lds);
        PH(9) for (int it = (G == 256 ? (bx ^ 64) : bx); it < 1040; it += G) hy_s3_item(p, layer, it);
        xcd_barrier(xb);
        PH(10) gla_s4(p);
        __syncthreads();
        PH(11) { pg8::PlainSched S{MX / 256, NGATE / 256, G, bx, (const char*)(p.ws + OFF_NB), (const char*)(p.ws + OFF_WIN) + (size_t)NMIX * D * 2, (size_t)256 * D * 2, (size_t)256 * D * 2, WG_A};
          pg8::EpiBf16<0> E{(bf16_t*)(p.ws + R_G), NGATE};
          pg8::gemm_phase(lds, D, D, D, S, E); }
        if (layer == 0) { PH(19) skinny_in(p, 1, lds); }
        xcd_barrier(xb);
        PH(12) { pg8::BranchSched S{MX / 256, D / 256, G, bx, (const char*)(p.ws + OFF_Z), (const char*)(p.ws + OFF_WBO), (size_t)256 * D * 2, (size_t)256 * W * 2, WG_N8};
          pg8::EpiBranch E{(bf16_t*)(p.ws + R_MB), (const bf16_t*)(p.ws + R_G)};
          pg8::gemm_phase(lds, D, W, W, S, E); }
        if (layer == 0) { PH(20) skinny_branch(p, lds); }
        xcd_barrier(xb);
        PH(13) { pg8::PlainSched S{MX / 256, D / 256, G, bx, (const char*)(p.ws + R_MB), (const char*)(p.ws + OFF_WOUT), (size_t)256 * D * 2, (size_t)256 * D * 2, WG_N8};
          pg8::EpiResid E{(float*)(p.ws + OFF_H), layer == 0 ? p.in[0] : (const float*)(p.ws + OFF_H)};
          pg8::gemm_phase(lds, D, D, D, S, E); }
        if (layer == 0) { PH(21) skinny_resid(p, (const bf16_t*)(p.ws + R_MB), D, (const bf16_t*)(p.ws + OFF_WOUT), D, lds); }
        xcd_barrier(xb);
        PH(14) norm_rows(p, 1, p.in[3] + layer * D, layer == 0 ? MP : MX);
        xcd_barrier(xb);
        PH(15) { pg8::PlainSched S{MX / 256, 2 * DFF / 256, G, bx, (const char*)(p.ws + OFF_NB), (const char*)(p.ws + OFF_WGU), (size_t)256 * D * 2, (size_t)256 * D * 2, 16};
          pg8::EpiSwiglu E{(bf16_t*)(p.ws + R_FF)};
          pg8::gemm_phase(lds, D, D, D, S, E); }
        if (layer == 0) { PH(22) skinny_swiglu(p, lds); }
        xcd_barrier(xb);
        PH(16) { pg8::PlainSched S{MX / 256, D / 256, G, bx, (const char*)(p.ws + R_FF), (const char*)(p.ws + OFF_WD), (size_t)256 * DFF * 2, (size_t)256 * DFF * 2, WG_N8};
          pg8::EpiResid E{(float*)(p.ws + OFF_H), (const float*)(p.ws + OFF_H)};
          pg8::gemm_phase(lds, DFF, DFF, DFF, S, E); }
        if (layer == 0) { PH(23) skinny_resid(p, (const bf16_t*)(p.ws + R_FF), DFF, (const bf16_t*)(p.ws + OFF_WD), DFF, lds); }
        xcd_barrier(xb);
    }
    PH(17) norm_rows(p, 3, p.in[27], MX);
}

#undef p
extern "C" void kernel_launch(void* const* d_in, const int* in_sizes, int n_in, void* d_out, int out_size,
                              void* d_ws, size_t ws_size, hipStream_t stream) {
    constexpr size_t kLds = 157696;
    static int grid_blocks = 0;
    if (!grid_blocks) {
        int dev = 0, cus = 0, per_cu = 0;
        hipGetDevice(&dev);
        hipDeviceGetAttribute(&cus, hipDeviceAttributeMultiprocessorCount, dev);
        hipFuncSetAttribute((const void*)mega, hipFuncAttributeMaxDynamicSharedMemorySize, (int)kLds);
        hipOccupancyMaxActiveBlocksPerMultiprocessor(&per_cu, (const void*)mega, 512, kLds);
        if (per_cu < 1) per_cu = 1;
        grid_blocks = cus * per_cu;
        if (ws_size < WS_TOTAL || n_in != 28) { fprintf(stderr, "kernel_launch: workspace %zu < %zu or n_in %d != 28\n", ws_size, (size_t)WS_NEED, n_in); grid_blocks = -1; }
    }
    if (grid_blocks < 0) return;
    if (hipMemsetAsync((char*)d_ws + OFF_BAR, 0, 16384, stream) != hipSuccess) { fprintf(stderr, "kernel_launch: memset failed\n"); return; }
    Params p{};
    for (int i = 0; i < 28; ++i) p.in[i] = (const float*)d_in[i];
    p.out = (float*)d_out; p.ws = (unsigned char*)d_ws; p.rep = REP_MASK; p.pad = 0;
    void* args[] = {&p};
    hipError_t e = hipLaunchCooperativeKernel((void*)mega, dim3(grid_blocks), dim3(512), args, kLds, stream);
    if (e != hipSuccess) fprintf(stderr, "cooperative launch failed: %s (grid %d)\n", hipGetErrorString(e), grid_blocks);
}
```

```cpp
#include <hip/hip_runtime.h>
#include <hip/hip_cooperative_groups.h>
#include <cstdio>
namespace cg = cooperative_groups;

#define LAS __attribute__((address_space(3)))
typedef unsigned short bf16_t;
typedef short bf16x8 __attribute__((ext_vector_type(8)));
typedef float f32x4 __attribute__((ext_vector_type(4)));
typedef float f32x2 __attribute__((ext_vector_type(2)));
typedef unsigned u32x4 __attribute__((ext_vector_type(4)));
typedef unsigned u32x2 __attribute__((ext_vector_type(2)));

constexpr int D = 2048, T = 8208, SEQ = 8192, W = 512, MP = 16640, MX = 16384, NMIX = 7168, NGATE = 8192, DFF = 5632, NCHK = 65;
constexpr int GRN = 18576, GROFF = 10240, UBLK = 136, UBT = 95 * 136, TF = 8320, FOFF = 112;
constexpr float EPS = 1e-6f;

constexpr size_t OFF_H = 0;
constexpr size_t OFF_NB = OFF_H + (size_t)MP * D * 4;
constexpr size_t OFF_Z = OFF_NB + (size_t)MP * D * 2;
constexpr size_t OFF_WIN = OFF_Z + (size_t)MP * D * 2;
constexpr size_t OFF_WBO = OFF_WIN + (size_t)15360 * 2048 * 2;
constexpr size_t OFF_WOUT = OFF_WBO + (size_t)4 * 2048 * 512 * 2;
constexpr size_t OFF_WGU = OFF_WOUT + (size_t)2048 * 2048 * 2;
constexpr size_t OFF_WD = OFF_WGU + (size_t)11264 * 2048 * 2;
constexpr size_t OFF_ROPE = OFF_WD + (size_t)2048 * 5632 * 2;
constexpr size_t OFF_R = OFF_ROPE + (size_t)T * 64 * 8;
constexpr size_t R_PMIX = OFF_R;
constexpr size_t R_O = R_PMIX + (size_t)MP * NMIX * 2;
constexpr size_t R_LA = R_O + (size_t)4 * MP * W * 2;
constexpr size_t R_BB = R_LA + (size_t)2 * MP * W * 2;
constexpr size_t R_U = R_BB + (size_t)2 * MP * W * 2;
constexpr size_t R_GG = R_U + (size_t)520 * 65536 * 4;
constexpr size_t R_UT = R_GG + (size_t)520 * 512 * 4;
constexpr size_t R_GR = R_UT + (size_t)512 * 2 * TF * 2;
constexpr size_t R_CA = R_GR + (size_t)512 * GRN * 2;
constexpr size_t R_CB = R_CA + (size_t)4 * 65 * 512 * 4;
constexpr size_t R_CR = R_CB + (size_t)4 * 65 * 512 * 4;
constexpr size_t R_YT = R_CR + (size_t)4 * 65 * 512 * 4;
constexpr size_t R_END1 = R_YT + (size_t)512 * 2 * TF * 2;
constexpr size_t R_G = R_LA;
constexpr size_t R_MB = OFF_R;
constexpr size_t R_FF = OFF_R + (size_t)MP * D * 2;
constexpr size_t WS_NEED = (R_G + (size_t)MP * NGATE * 2) > R_END1 ? (R_G + (size_t)MP * NGATE * 2) : R_END1;
static_assert(R_END1 <= WS_NEED, "scratch");
constexpr size_t OFF_BAR = (WS_NEED + 255) & ~(size_t)255;
constexpr size_t OFF_LRUW = OFF_BAR + 16384;
constexpr size_t OFF_LBT = OFF_LRUW + 262144;
constexpr size_t WS_TOTAL = OFF_LBT + 2048;
static_assert(WS_TOTAL <= (size_t)1006632960, "workspace too large");
static_assert(R_FF + (size_t)MP * DFF * 2 <= WS_NEED, "ff");

struct Params { const float* in[28]; float* out; unsigned char* ws; int rep; int pad; };
typedef const __attribute__((address_space(4))) Params CParams;

__device__ __forceinline__ float bf2f(bf16_t b) { return __uint_as_float(((unsigned)b) << 16); }
typedef __bf16 bf16v2 __attribute__((ext_vector_type(2)));
__device__ __forceinline__ unsigned pk2(float lo, float hi) { const f32x2 v = {lo, hi}; const bf16v2 b = __builtin_convertvector(v, bf16v2); return __builtin_bit_cast(unsigned, b); }
__device__ __forceinline__ unsigned f2bf(float f) { return pk2(f, 0.f) & 0xffffu; }
__device__ __forceinline__ float sigm(float x) { return __builtin_amdgcn_rcpf(1.0f + __expf(-x)); }
__device__ __forceinline__ float siluf(float x) { return x * sigm(x); }
__device__ __forceinline__ float gelu_tanh(float x) { return 0.5f * x * (1.0f + tanhf(0.7978845608028654f * (x + 0.044715f * x * x * x))); }
__device__ __forceinline__ int row_of(int b, int t) { return t < 16 ? (MX + b * 128 + 112 + t) : (b * SEQ + (t - 16)); }
__device__ __forceinline__ int row_bci(int b, int c, int i) { return c == 0 ? (MX + b * 128 + i) : (b * SEQ + (c - 1) * 128 + i); }
__device__ __forceinline__ int opaque_tid() { int t = threadIdx.x; asm volatile("" : "+v"(t)); return t; }
#define LDS_WAIT() asm volatile("s_waitcnt lgkmcnt(0)" ::: "memory")

namespace pg8 {
constexpr int BM = 256, BK = 64, HALF = 128, HTB = HALF * BK * 2, NXCD = 8, WGM = 8;
__device__ __forceinline__ int lds_byte(int r, int c) { const int st = (r >> 4) * 2 + (c >> 5), rr = r & 15, cc = c & 31, ob = rr * 64 + cc * 2; return st * 1024 + (ob ^ (((ob >> 9) & 1) << 5)); }
__device__ __forceinline__ void stage_rc(int b, int& R, int& C) { const int st = b / 1024, sb = b % 1024, swz = sb ^ (((sb >> 9) & 1) << 5); R = (st >> 1) * 16 + swz / 64; C = (st & 1) * 32 + (swz % 64) / 2; }
__device__ __forceinline__ int perm32(int rho) { const int n = rho >> 4, i = rho & 15; return 8 * (i >> 2) + 4 * n + (i & 3); }
struct Unit { int pm, pn, z; };
__device__ __forceinline__ bool tile_of(long L, int nM, int nN, int WGMr, int& pm, int& pn) {
    const int nwg = nM * nN; if (L >= nwg) return false;
    int wgid = (int)L; { const int q = nwg / NXCD, r = nwg % NXCD, xcd = wgid % NXCD, off = wgid / NXCD; wgid = (xcd < r ? xcd * (q + 1) : r * (q + 1) + (xcd - r) * q) + off; }
    const int nig = WGMr * nN, gid = wgid / nig, fm = gid * WGMr, gsz = (nM - fm) < WGMr ? (nM - fm) : WGMr;
    pm = fm + ((wgid % nig) % gsz); pn = (wgid % nig) / gsz; return true;
}
struct PlainSched {
    int nM, nN, G, c; const char* A; const char* B; size_t at, bt; int wgm;
    __device__ __forceinline__ bool next(int i, Unit& u) const { u.z = 0; return tile_of((long)i * G + c, nM, nN, wgm, u.pm, u.pn); }
    __device__ __forceinline__ const char* aptr(const Unit& u) const { return A + (size_t)u.pm * at; }
    __device__ __forceinline__ const char* bptr(const Unit& u) const { return B + (size_t)u.pn * bt; }
};
struct BranchSched {
    int nM, nN, G, c; const char* A; const char* B; size_t at, bt; int wgm;
    __device__ __forceinline__ bool next(int i, Unit& u) const { u.z = i & 3; return tile_of((long)(i >> 2) * G + c, nM, nN, wgm, u.pm, u.pn); }
    __device__ __forceinline__ const char* aptr(const Unit& u) const { return A + (size_t)u.pm * at + (size_t)u.z * (W * 2); }
    __device__ __forceinline__ const char* bptr(const Unit& u) const { return B + (size_t)u.z * ((size_t)D * W * 2) + (size_t)u.pn * bt; }
};

template <int ACT> struct EpiBf16 {
    static constexpr bool PERM = true;
    bf16_t* O; int ldc;
    __device__ __forceinline__ void operator()(const f32x4 (&acc)[2][2][4][2], const Unit& u, int wr, int wc, int fr, int fq) const {
        const int row0 = u.pm * BM + wr * 64 + fr, col0 = u.pn * BM + wc * 32 + 8 * fq;
#pragma unroll
        for (int ai = 0; ai < 2; ++ai)
#pragma unroll
            for (int m = 0; m < 4; ++m) { bf16_t* rowp = O + (size_t)(row0 + ai * HALF + m * 16) * ldc + col0;
#pragma unroll
                for (int bj = 0; bj < 2; ++bj) { f32x4 v0 = acc[ai][bj][m][0], v1 = acc[ai][bj][m][1];
                    if (ACT == 1) {
#pragma unroll
                        for (int j = 0; j < 4; ++j) { v0[j] = sigm(v0[j]); v1[j] = sigm(v1[j]); } }
                    u32x4 w; w.x = pk2(v0[0], v0[1]); w.y = pk2(v0[2], v0[3]); w.z = pk2(v1[0], v1[1]); w.w = pk2(v1[2], v1[3]);
                    *(u32x4*)(rowp + bj * HALF) = w; } }
    }
};
struct EpiBranch {
    static constexpr bool PERM = true;
    bf16_t* MB; const bf16_t* G;
    __device__ __forceinline__ void operator()(const f32x4 (&acc)[2][2][4][2], const Unit& u, int wr, int wc, int fr, int fq) const {
        const int row0 = u.pm * BM + wr * 64 + fr, col0 = u.pn * BM + wc * 32 + 8 * fq;
#pragma unroll
        for (int ai = 0; ai < 2; ++ai)
#pragma unroll
          for (int mp = 0; mp < 2; ++mp) {
            u32x4 g[2][2], pv[2][2];
#pragma unroll
            for (int mm = 0; mm < 2; ++mm)
#pragma unroll
                for (int bj = 0; bj < 2; ++bj) { const size_t r = (size_t)(row0 + ai * HALF + (2 * mp + mm) * 16);
                    g[mm][bj] = *(const u32x4*)(G + r * NGATE + u.z * D + col0 + bj * HALF);
                    pv[mm][bj] = (u32x4){0u, 0u, 0u, 0u}; if (u.z) pv[mm][bj] = *(const u32x4*)(MB + r * D + col0 + bj * HALF); }
#pragma unroll
            for (int mm = 0; mm < 2; ++mm)
#pragma unroll
                for (int bj = 0; bj < 2; ++bj) { const int m = 2 * mp + mm; const size_t r = (size_t)(row0 + ai * HALF + m * 16);
                    const f32x4 v0 = acc[ai][bj][m][0], v1 = acc[ai][bj][m][1];
                    float o[8];
                    o[0] = v0[0]; o[1] = v0[1]; o[2] = v0[2]; o[3] = v0[3]; o[4] = v1[0]; o[5] = v1[1]; o[6] = v1[2]; o[7] = v1[3];
                    u32x4 w;
#pragma unroll
                    for (int q = 0; q < 4; ++q) {
                        const float g0 = sigm(__uint_as_float(g[mm][bj][q] << 16)), g1 = sigm(__uint_as_float(g[mm][bj][q] & 0xffff0000u));
                        const float p0 = __uint_as_float(pv[mm][bj][q] << 16), p1 = __uint_as_float(pv[mm][bj][q] & 0xffff0000u);
                        w[q] = pk2(p0 + g0 * o[2 * q], p1 + g1 * o[2 * q + 1]); }
                    *(u32x4*)(MB + r * D + col0 + bj * HALF) = w; } }
    }
};
struct EpiResid {
    static constexpr bool PERM = false;
    float* H; const float* S;
    __device__ __forceinline__ void operator()(const f32x4 (&acc)[2][2][4][2], const Unit& u, int wr, int wc, int fr, int fq) const {
        const int row0 = u.pm * BM + wr * 64 + fr, col0 = u.pn * BM + wc * 32 + 4 * fq;
#pragma unroll
        for (int ai = 0; ai < 2; ++ai)
#pragma unroll
            for (int mp = 0; mp < 2; ++mp) {
                f32x4 old[2][2][2];
#pragma unroll
                for (int mm = 0; mm < 2; ++mm)
#pragma unroll
                    for (int bj = 0; bj < 2; ++bj)
#pragma unroll
                        for (int n = 0; n < 2; ++n) old[mm][bj][n] = *(const f32x4*)(S + (size_t)(row0 + ai * HALF + (2 * mp + mm) * 16) * D + col0 + bj * HALF + n * 16);
#pragma unroll
                for (int mm = 0; mm < 2; ++mm)
#pragma unroll
                    for (int bj = 0; bj < 2; ++bj)
#pragma unroll
                        for (int n = 0; n < 2; ++n) *(f32x4*)(H + (size_t)(row0 + ai * HALF + (2 * mp + mm) * 16) * D + col0 + bj * HALF + n * 16) = old[mm][bj][n] + acc[ai][bj][2 * mp + mm][n]; }
    }
};
struct EpiSwiglu {
    static constexpr bool PERM = true;
    bf16_t* FF;
    __device__ __forceinline__ void operator()(const f32x4 (&acc)[2][2][4][2], const Unit& u, int wr, int wc, int fr, int fq) const {
        const int row0 = u.pm * BM + wr * 64 + fr, col0 = u.pn * HALF + wc * 32 + 8 * fq;
#pragma unroll
        for (int ai = 0; ai < 2; ++ai)
#pragma unroll
            for (int m = 0; m < 4; ++m) { bf16_t* rowp = FF + (size_t)(row0 + ai * HALF + m * 16) * DFF + col0;
                const f32x4 g0 = acc[ai][0][m][0], g1 = acc[ai][0][m][1], u0 = acc[ai][1][m][0], u1 = acc[ai][1][m][1];
                u32x4 w; w.x = pk2(siluf(g0[0]) * u0[0], siluf(g0[1]) * u0[1]); w.y = pk2(siluf(g0[2]) * u0[2], siluf(g0[3]) * u0[3]);
                w.z = pk2(siluf(g1[0]) * u1[0], siluf(g1[1]) * u1[1]); w.w = pk2(siluf(g1[2]) * u1[2], siluf(g1[3]) * u1[3]);
                *(u32x4*)rowp = w; }
    }
};

template <class Epi, class Sched>
__device__ __forceinline__ void gemm_phase(LAS unsigned char* lds, const int lda, const int ldb, const int K, const Sched& S, const Epi& E) {
    const int tid = opaque_tid(), wid = __builtin_amdgcn_readfirstlane(tid >> 6), lane = tid & 63, wr = wid >> 2, wc = wid & 3, fr = lane & 15, fq = lane >> 4;
    const int nt = K / BK;
    unsigned voffA[2], voffB[2];
#pragma unroll
    for (int i = 0; i < 2; ++i) { int R, C; stage_rc(tid * 16 + i * 8192, R, C); const int Rb = Epi::PERM ? ((R & ~31) + perm32(R & 31)) : R;
        voffA[i] = (unsigned)(R * lda + C) * 2u; voffB[i] = (unsigned)(Rb * ldb + C) * 2u; }
    const size_t kstep = (size_t)(BK * 2);
    const size_t hstepA = (size_t)HALF * lda * 2, hstepB = (size_t)HALF * ldb * 2;
    const unsigned ldsw = (unsigned)wid * 1024u;
    const int aoff = lds_byte(wr * 64 + fr, fq * 8), boff = lds_byte(wc * 32 + fr, fq * 8);
#define PG8_SA(b, h) (((b) * 2 + (h)) * HTB)
#define PG8_SB(b, h) ((4 + (b) * 2 + (h)) * HTB)
#define PG8_STAGE(bufoff, gbase, voff) do { _Pragma("unroll") for (int _i = 0; _i < 2; ++_i) \
        __builtin_amdgcn_global_load_lds((const unsigned*)((const char*)(gbase) + (voff)[_i]), (LAS unsigned*)(lds + (bufoff) + ldsw + _i * 8192), 16, 0, 0); } while (0)
#define PG8_LDA(dst, b, h) do { _Pragma("unroll") for (int m = 0; m < 4; ++m) _Pragma("unroll") for (int k = 0; k < 2; ++k) dst[m][k] = *(const LAS bf16x8*)(lds + PG8_SA(b, h) + aoff + m * 2048 + k * 1024); } while (0)
#define PG8_LDB(dst, b, h) do { _Pragma("unroll") for (int n = 0; n < 2; ++n) _Pragma("unroll") for (int k = 0; k < 2; ++k) dst[n][k] = *(const LAS bf16x8*)(lds + PG8_SB(b, h) + boff + n * 2048 + k * 1024); } while (0)
#define PG8_MMA(ai, bj, At, Bt) do { __builtin_amdgcn_s_setprio(1); _Pragma("unroll") for (int m = 0; m < 4; ++m) _Pragma("unroll") for (int n = 0; n < 2; ++n) _Pragma("unroll") for (int k = 0; k < 2; ++k) \
        acc[ai][bj][m][n] = __builtin_amdgcn_mfma_f32_16x16x32_bf16(Bt[n][k], At[m][k], acc[ai][bj][m][n], 0, 0, 0); __builtin_amdgcn_s_setprio(0); } while (0)
#define PG8_WAIT_V(n) asm volatile("s_waitcnt vmcnt(" #n ")" ::: "memory")
#define PG8_WAIT_L(n) asm volatile("s_waitcnt lgkmcnt(" #n ")" ::: "memory")
#define PG8_BAR __builtin_amdgcn_s_barrier()
#define PG8_SCHED __builtin_amdgcn_sched_barrier(0)
    Unit cur, nxt; int ui = 0;
    if (!S.next(0, cur)) return;
    f32x4 acc[2][2][4][2];
#pragma unroll
    for (int a = 0; a < 2; ++a)
#pragma unroll
        for (int b = 0; b < 2; ++b)
#pragma unroll
            for (int m = 0; m < 4; ++m)
#pragma unroll
                for (int n = 0; n < 2; ++n) acc[a][b][m][n] = (f32x4){0.f, 0.f, 0.f, 0.f};
    bf16x8 At[4][2], B0[2][2], B1[2][2];
    const char* cA = S.aptr(cur); const char* cB = S.bptr(cur);
    PG8_STAGE(PG8_SB(0, 0), cB, voffB); PG8_STAGE(PG8_SA(0, 0), cA, voffA); PG8_STAGE(PG8_SB(0, 1), cB + hstepB, voffB); PG8_STAGE(PG8_SA(0, 1), cA + hstepA, voffA);
    if (wr == 1) PG8_BAR;
    PG8_WAIT_V(4); PG8_BAR;
    PG8_STAGE(PG8_SB(1, 0), cB + kstep, voffB); PG8_STAGE(PG8_SA(1, 0), cA + kstep, voffA); PG8_STAGE(PG8_SB(1, 1), cB + hstepB + kstep, voffB);
    PG8_WAIT_V(6); PG8_BAR;
    for (;;) {
        const bool has_next = S.next(ui + 1, nxt);
        const char* nA = has_next ? S.aptr(nxt) : cA; const char* nB = has_next ? S.bptr(nxt) : cB;
        for (int t = 0; t < nt; t += 2) {
            const bool last = (t == nt - 2);
            const char* a1 = cA + (size_t)(t + 1) * kstep;
            const char* a2 = last ? nA : cA + (size_t)(t + 2) * kstep; const char* b2 = last ? nB : cB + (size_t)(t + 2) * kstep;
            const char* a3 = a2 + kstep; const char* b3 = b2 + kstep;
            PG8_LDB(B0, 0, 0); PG8_SCHED; PG8_LDA(At, 0, 0); PG8_STAGE(PG8_SA(1, 1), a1 + hstepA, voffA);
            PG8_WAIT_L(8); PG8_BAR; PG8_WAIT_L(0); PG8_MMA(0, 0, At, B0); PG8_BAR; PG8_SCHED;
            PG8_LDB(B1, 0, 1); PG8_STAGE(PG8_SB(0, 0), b2, voffB);
            PG8_BAR; PG8_WAIT_L(0); PG8_MMA(0, 1, At, B1); PG8_BAR;
            PG8_LDA(At, 0, 1); PG8_STAGE(PG8_SA(0, 0), a2, voffA);
            PG8_BAR; PG8_WAIT_L(0); PG8_MMA(1, 0, At, B0); PG8_BAR; PG8_SCHED;
            PG8_STAGE(PG8_SB(0, 1), b2 + hstepB, voffB);
            PG8_WAIT_V(6); PG8_BAR; PG8_MMA(1, 1, At, B1); PG8_BAR;
            PG8_LDB(B0, 1, 0); PG8_SCHED; PG8_LDA(At, 1, 0); PG8_STAGE(PG8_SA(0, 1), a2 + hstepA, voffA);
            PG8_WAIT_L(8); PG8_BAR; PG8_WAIT_L(0); PG8_MMA(0, 0, At, B0); PG8_BAR; PG8_SCHED;
            PG8_LDB(B1, 1, 1); PG8_STAGE(PG8_SB(1, 0), b3, voffB);
            PG8_BAR; PG8_WAIT_L(0); PG8_MMA(0, 1, At, B1); PG8_BAR;
            PG8_LDA(At, 1, 1); PG8_STAGE(PG8_SA(1, 0), a3, voffA);
            PG8_BAR; PG8_WAIT_L(0); PG8_MMA(1, 0, At, B0); PG8_BAR; PG8_SCHED;
            PG8_STAGE(PG8_SB(1, 1), b3 + hstepB, voffB);
            PG8_WAIT_V(6); PG8_BAR; PG8_MMA(1, 1, At, B1); PG8_BAR;
        }
        E(acc, cur, wr, wc, fr, fq);
        if (!has_next) break;
#pragma unroll
        for (int a = 0; a < 2; ++a)
#pragma unroll
            for (int b = 0; b < 2; ++b)
#pragma unroll
                for (int m = 0; m < 4; ++m)
#pragma unroll
                    for (int n = 0; n < 2; ++n) acc[a][b][m][n] = (f32x4){0.f, 0.f, 0.f, 0.f};
        cur = nxt; cA = nA; cB = nB; ++ui;
    }
    PG8_WAIT_V(0);
    if (wr == 0) PG8_BAR;
    PG8_BAR;
#undef PG8_SA
#undef PG8_SB
#undef PG8_STAGE
#undef PG8_LDA
#undef PG8_LDB
#undef PG8_MMA
#undef PG8_WAIT_V
#undef PG8_WAIT_L
#undef PG8_BAR
#undef PG8_SCHED
}
}

struct XpItem { const float* src; bf16_t* dst; int K, N, k0, n0, row0; };
__device__ __forceinline__ void xpose_load(const XpItem& x, int lane, f32x4 (&v)[8]) {
#pragma unroll
    for (int i = 0; i < 8; ++i) v[i] = *(const f32x4*)(x.src + (size_t)(x.k0 + 8 * i + (lane >> 3)) * x.N + x.n0 + (lane & 7) * 4);
}
__device__ __forceinline__ void xpose_finish(const XpItem& x, int lane, const f32x4 (&v)[8], LAS float* scr) {
#pragma unroll
    for (int i = 0; i < 8; ++i) { LAS float* d = scr + (8 * i + (lane >> 3)) * 33 + (lane & 7) * 4; d[0] = v[i][0]; d[1] = v[i][1]; d[2] = v[i][2]; d[3] = v[i][3]; }
    LDS_WAIT(); asm volatile("" ::: "memory");
    const int c = lane & 7;
#pragma unroll
    for (int j = 0; j < 4; ++j) { const int n = (lane >> 3) + 8 * j; const LAS float* s = scr + (8 * c) * 33 + n;
        u32x4 o; o.x = pk2(s[0 * 33], s[1 * 33]); o.y = pk2(s[2 * 33], s[3 * 33]); o.z = pk2(s[4 * 33], s[5 * 33]); o.w = pk2(s[6 * 33], s[7 * 33]);
        *(u32x4*)(x.dst + (size_t)(x.row0 + n) * x.K + x.k0 + 8 * c) = o; }
    LDS_WAIT(); asm volatile("" ::: "memory");
}

__device__ __forceinline__ float wave_sum(float v) {
#pragma unroll
    for (int o = 1; o < 64; o <<= 1) v += __shfl_xor(v, o);
    return v;
}

__device__ __forceinline__ void norm_rows(CParams& p, int mode, const float* gain, int nrows) {
    float* H = (float*)(p.ws + OFF_H); bf16_t* NB = (bf16_t*)(p.ws + OFF_NB);
    const int tid0 = opaque_tid(); const int lane = tid0 & 63, gw = blockIdx.x * 8 + (tid0 >> 6), NW = gridDim.x * 8;
    for (int row = gw; row < nrows; row += NW) {
        f32x4 v[8];
        if (mode == 0) {
            const float* src = nullptr;
            if (row < MX) src = p.in[0] + (size_t)row * D;
            else { const int i = (row - MX) & 127; if (i >= 112) src = p.in[1] + (size_t)(i - 112) * D; }
#pragma unroll
            for (int j = 0; j < 8; ++j) { v[j] = src ? *(const f32x4*)(src + (lane + 64 * j) * 4) : (f32x4){0.f, 0.f, 0.f, 0.f}; if (row >= MX) *(f32x4*)(H + (size_t)row * D + (lane + 64 * j) * 4) = v[j]; }
        } else {
#pragma unroll
            for (int j = 0; j < 8; ++j) v[j] = *(const f32x4*)(H + (size_t)row * D + (lane + 64 * j) * 4);
        }
        float s = 0.f;
#pragma unroll
        for (int j = 0; j < 8; ++j) s += (v[j][0] * v[j][0] + v[j][1] * v[j][1]) + (v[j][2] * v[j][2] + v[j][3] * v[j][3]);
        const float rs = 1.0f / sqrtf(wave_sum(s) * (1.0f / D) + EPS);
#pragma unroll
        for (int j = 0; j < 8; ++j) {
            const f32x4 g = *(const f32x4*)(gain + (lane + 64 * j) * 4);
            const f32x4 y = v[j] * rs * g;
            if (mode == 3) *(f32x4*)(p.out + (size_t)row * D + (lane + 64 * j) * 4) = y;
            else { u32x2 w; w.x = pk2(y[0], y[1]); w.y = pk2(y[2], y[3]); *(u32x2*)(NB + (size_t)row * D + (lane + 64 * j) * 4) = w; }
        }
    }
}

constexpr int FPOS = 36;
__device__ __forceinline__ void filter_item(CParams& p, int layer, int it, LAS float* l) {
    LAS float* Zf = l; LAS float* H1 = l + FPOS * 33; LAS float* H2T = H1 + FPOS * 64;
    LAS float* W1L = H2T + 64 * FPOS; LAS float* W2L = W1L + 33 * 64;
    const int tid = opaque_tid(), n0 = it * FPOS;
    const float* w1 = p.in[14] + layer * 33 * 64; const float* b1 = p.in[15] + layer * 64; const float* w2 = p.in[16] + layer * 64 * 64;
    const float* b2 = p.in[17] + layer * 64; const float* w3 = p.in[18] + layer * 64 * 1024; const float* decay = p.in[19] + layer * 1024;
    bf16_t* GR = (bf16_t*)(p.ws + R_GR);
    __syncthreads();
    {
        const f32x4 t0 = *(const f32x4*)(w1 + 4 * tid), t2 = *(const f32x4*)(w2 + 4 * tid), t3 = *(const f32x4*)(w2 + 2048 + 4 * tid);
        f32x4 t1 = (f32x4){0.f, 0.f, 0.f, 0.f}; if (tid < 16) t1 = *(const f32x4*)(w1 + 2048 + 4 * tid);
        *(LAS f32x4*)(W1L + 4 * tid) = t0; if (tid < 16) *(LAS f32x4*)(W1L + 2048 + 4 * tid) = t1;
        *(LAS f32x4*)(W2L + 4 * tid) = t2; *(LAS f32x4*)(W2L + 2048 + 4 * tid) = t3; }
    for (int idx = tid; idx < FPOS * 33; idx += 512) { const int pos = idx / 33, e = idx % 33, n = n0 + pos; float v;
        if (e == 0) v = (float)n / 8207.0f;
        else { const int k = (e - 1) & 15; const float fr = 1e-4f + (float)k * ((15.0f - 1e-4f) / 15.0f); const double rev = (double)n * (double)fr * (1.0 / 8208.0); const float fx = (float)(rev - floor(rev));
               v = (e <= 16) ? __builtin_amdgcn_cosf(fx) : -__builtin_amdgcn_sinf(fx); }
        Zf[pos * 33 + e] = v; }
    __syncthreads();
    for (int pos = tid >> 4; pos < FPOS; pos += 32) { const int k4 = (tid & 15) * 4; float a[4];
#pragma unroll
      for (int q = 0; q < 4; ++q) a[q] = b1[k4 + q];
#pragma unroll 3
      for (int e = 0; e < 33; ++e) { const float z = Zf[pos * 33 + e];
#pragma unroll
          for (int q = 0; q < 4; ++q) a[q] += z * W1L[e * 64 + k4 + q]; }
#pragma unroll
      for (int q = 0; q < 4; ++q) H1[pos * 64 + k4 + q] = __builtin_amdgcn_sinf(a[q] * 0.15915494309189535f); }
    __syncthreads();
    for (int pos = tid >> 4; pos < FPOS; pos += 32) { const int k4 = (tid & 15) * 4; float a[4];
#pragma unroll
      for (int q = 0; q < 4; ++q) a[q] = b2[k4 + q];
#pragma unroll 4
      for (int j = 0; j < 64; ++j) { const float z = H1[pos * 64 + j];
#pragma unroll
          for (int q = 0; q < 4; ++q) a[q] += z * W2L[j * 64 + k4 + q]; }
#pragma unroll
      for (int q = 0; q < 4; ++q) H2T[(k4 + q) * FPOS + pos] = __builtin_amdgcn_sinf(a[q] * 0.15915494309189535f); }
    __syncthreads();
    { float acc0[FPOS], acc1[FPOS];
#pragma unroll
      for (int q = 0; q < FPOS; ++q) { acc0[q] = 0.f; acc1[q] = 0.f; }
#pragma unroll 1
      for (int k8 = 0; k8 < 64; k8 += 8) { float wa8[8], wb8[8];
#pragma unroll
        for (int kk = 0; kk < 8; ++kk) { wa8[kk] = w3[(k8 + kk) * 1024 + tid]; wb8[kk] = w3[(k8 + kk) * 1024 + 512 + tid]; }
#pragma unroll
        for (int kk = 0; kk < 8; ++kk) { const int k = k8 + kk; const float wa = wa8[kk], wb = wb8[kk];
#pragma unroll
          for (int p4 = 0; p4 < FPOS / 4; ++p4) { const f32x4 h = *(const LAS f32x4*)(H2T + k * FPOS + p4 * 4);
#pragma unroll
              for (int q = 0; q < 4; ++q) { acc0[4 * p4 + q] += h[q] * wa; acc1[4 * p4 + q] += h[q] * wb; } } } }
      const float da = fabsf(decay[tid]), db = fabsf(decay[512 + tid]);
      static_assert(T % FPOS == 0 && FPOS % 4 == 0 && (GROFF % 4) == 0, "filter store grouping");
      bf16_t* gf = GR + (size_t)tid * GRN + (GROFF - n0);
      bf16_t* gb = GR + (size_t)tid * GRN + (GROFF + n0);
      const float sa = -da / 8207.0f, sb = -db / 8207.0f;
#define FE0(q) (acc0[q] * __expf(sa * (float)(n0 + (q))))
#define FE1(q) (acc1[q] * __expf(sb * (float)(n0 + (q))))
      gf[0] = (bf16_t)f2bf(FE0(0));
#pragma unroll
      for (int k = 1; k <= 8; ++k) { u32x2 w; w.x = pk2(FE0(4 * k), FE0(4 * k - 1)); w.y = pk2(FE0(4 * k - 2), FE0(4 * k - 3)); *(u32x2*)(gf - 4 * k) = w; }
      *(unsigned*)(gf - 34) = pk2(FE0(34), FE0(33));
      gf[-35] = (bf16_t)f2bf(FE0(35));
      if (it == 0) { gb[1] = (bf16_t)f2bf(FE1(1)); gb[2] = (bf16_t)f2bf(FE1(2)); gb[3] = (bf16_t)f2bf(FE1(3)); }
      else { u32x2 w; w.x = pk2(FE1(0), FE1(1)); w.y = pk2(FE1(2), FE1(3)); *(u32x2*)gb = w; }
#pragma unroll
      for (int k = 1; k < 9; ++k) { u32x2 w; w.x = pk2(FE1(4 * k), FE1(4 * k + 1)); w.y = pk2(FE1(4 * k + 2), FE1(4 * k + 3)); *(u32x2*)(gb + 4 * k) = w; }
#undef FE0
#undef FE1
    }
}

__device__ __forceinline__ void phase_prep(CParams& p, int layer, LAS unsigned char* lds) {
    const int tid = opaque_tid(), lane = tid & 63, wave = tid >> 6;
    for (int it = blockIdx.x; it < (T + FPOS - 1) / FPOS; it += gridDim.x) filter_item(p, layer, it, (LAS float*)lds);
    __syncthreads();
    if (layer == 0) {
        f32x2* RT = (f32x2*)(p.ws + OFF_ROPE);
        for (int idx = blockIdx.x * 512 + tid; idx < T * 64; idx += gridDim.x * 512) { const int pos = idx >> 6, j = idx & 63;
            double inv = 1.0; for (int q = 0; q < j; ++q) inv *= 0.8659643233600653; const double rev = (double)pos * inv * 0.15915494309189535; const float fx = (float)(rev - floor(rev));
            RT[idx] = (f32x2){__builtin_amdgcn_cosf(fx), __builtin_amdgcn_sinf(fx)}; }
    }
    if (blockIdx.x == 0) { const float l0 = p.in[21][tid], l1 = p.in[21][W + tid]; ((float*)(p.ws + OFF_LBT))[tid] = (layer == 1) ? 1.0f / (1.0f + expf(l0 - l1)) : 0.f; }
    { bf16_t* Wg = (bf16_t*)(p.ws + OFF_LRUW);
      for (int idx = blockIdx.x * 512 + tid; idx < 131072; idx += gridDim.x * 512) { const int i = idx & 63, jj = (idx >> 6) & 63, kb = (idx >> 12) & 7, m = idx >> 15;
          const float* src = (m & 1) ? p.in[9] : p.in[7]; Wg[idx] = (bf16_t)f2bf(src[(size_t)((layer * 2 + (m >> 1)) * 8 + kb) * 4096 + i * 64 + jj]); } }
    LAS float* scr = (LAS float*)lds + wave * (64 * 33);
    const int gw = blockIdx.x * 8 + wave, NW = gridDim.x * 8;
    constexpr int I_IN = 32 * 480, I_BO = 8 * 64, I_OUT = 32 * 64, I_G = 32 * 176, I_D = 88 * 64;
    constexpr int NIT = I_IN + 4 * I_BO + I_OUT + 2 * I_G + I_D;
    auto decode = [&](int it, XpItem& x) {
        int r = it;
        if (r < I_IN) { const int nb = r % 480, kb = r / 480; x = XpItem{p.in[4] + (size_t)layer * D * 15360, (bf16_t*)(p.ws + OFF_WIN), D, 15360, kb * 64, nb * 32, nb * 32}; return; } r -= I_IN;
        if (r < 4 * I_BO) { const int z = r / I_BO, q = r % I_BO, nb = q % 64, kb = q / 64;
            x = XpItem{p.in[22] + ((size_t)layer * 4 + z) * W * D, (bf16_t*)(p.ws + OFF_WBO) + (size_t)z * D * W, W, D, kb * 64, nb * 32, nb * 32}; return; } r -= 4 * I_BO;
        if (r < I_OUT) { const int nb = r % 64, kb = r / 64; x = XpItem{p.in[23] + (size_t)layer * D * D, (bf16_t*)(p.ws + OFF_WOUT), D, D, kb * 64, nb * 32, nb * 32}; return; } r -= I_OUT;
        if (r < 2 * I_G) { const int up = r / I_G, q = r % I_G, nb = q % 176, kb = q / 176, n0 = nb * 32;
            x = XpItem{p.in[up ? 25 : 24] + (size_t)layer * D * DFF, (bf16_t*)(p.ws + OFF_WGU), D, DFF, kb * 64, n0, 256 * (n0 >> 7) + (n0 & 127) + up * 128}; return; } r -= 2 * I_G;
        { const int nb = r % 64, kb = r / 64; x = XpItem{p.in[26] + (size_t)layer * DFF * D, (bf16_t*)(p.ws + OFF_WD), DFF, D, kb * 64, nb * 32, nb * 32}; }
    };
    {
        XpItem cur, nxt; f32x4 vc[8], vn[8];
        int it = gw;
        if (it < NIT) { decode(it, cur); xpose_load(cur, lane, vc); }
        for (; it < NIT; it += NW) {
            const bool hn = (it + NW) < NIT;
            if (hn) { decode(it + NW, nxt); xpose_load(nxt, lane, vn); }
            xpose_finish(cur, lane, vc, scr);
            if (hn) { cur = nxt;
#pragma unroll
                for (int i = 0; i < 8; ++i) vc[i] = vn[i]; }
        }
    }
    norm_rows(p, layer == 0 ? 0 : 1, p.in[2] + layer * D, MP);
}

__device__ __forceinline__ void lru_s1_item(CParams& p, int layer, int item, LAS unsigned char* lds) {
    const int cidx = item >> 3, kb = item & 7, b = cidx / NCHK, c = cidx % NCHK;
    const int tid = opaque_tid(), lane = tid & 63, wave = tid >> 6;
    constexpr int XS = 72;
    LAS bf16_t* XCb = (LAS bf16_t*)lds;
    LAS bf16_t* WT = XCb + 128 * XS;
    LAS float* XCf = (LAS float*)(lds + (128 + 256) * XS * 2);
    LAS float* AG = XCf + 8192;
    const bf16_t* P = (const bf16_t*)(p.ws + R_PMIX);
    bf16_t* LA = (bf16_t*)(p.ws + R_LA); bf16_t* BB = (bf16_t*)(p.ws + R_BB);
    __syncthreads();
    {
        const bf16_t* Wg = (const bf16_t*)(p.ws + OFF_LRUW);
        for (int q = tid; q < 2048; q += 512) { const int n = q >> 3, part = q & 7, m = n >> 6, jj = n & 63;
            *(LAS u32x4*)(WT + n * XS + part * 8) = *(const u32x4*)(Wg + ((size_t)(m * 8 + kb) * 64 + jj) * 64 + part * 8); } }
    {
        const int j = tid & 63, tq = tid >> 6, ch = kb * 64 + j;
        const float* cw = p.in[5] + layer * 4 * W; const float cb = p.in[6][layer * W + ch];
        const float w0 = cw[ch], w1 = cw[W + ch], w2 = cw[2 * W + ch], w3 = cw[3 * W + ch];
        const int t0 = c * 128 + 16 * tq - 112;
        float xv[19];
#pragma unroll
        for (int q = 0; q < 19; ++q) { const int t = t0 - 2 + q; xv[q] = (t >= 0 && t < T) ? bf2f(P[(size_t)row_of(b, t) * NMIX + ch]) : 0.f; }
#pragma unroll
        for (int tt = 0; tt < 16; ++tt) { const float x = cb + w0 * xv[tt] + w1 * xv[tt + 1] + w2 * xv[tt + 2] + w3 * xv[tt + 3];
            XCf[(16 * tq + tt) * 64 + j] = x; XCb[(16 * tq + tt) * XS + j] = (bf16_t)f2bf(x); } }
    __syncthreads();
    const int r = lane & 15, h = lane >> 4;
    f32x4 acc[16];
#pragma unroll
    for (int nt = 0; nt < 16; ++nt) acc[nt] = (f32x4){0.f, 0.f, 0.f, 0.f};
#pragma unroll
    for (int ks = 0; ks < 2; ++ks) { const bf16x8 a = *(const LAS bf16x8*)(XCb + (16 * wave + r) * XS + 32 * ks + 8 * h);
#pragma unroll
        for (int nt = 0; nt < 16; ++nt) { const bf16x8 bw = *(const LAS bf16x8*)(WT + (16 * nt + r) * XS + 32 * ks + 8 * h);
            acc[nt] = __builtin_amdgcn_mfma_f32_16x16x32_bf16(a, bw, acc[nt], 0, 0, 0); } }
    const int tok0 = 16 * wave + 4 * h, t0 = c * 128 + tok0 - 112;
#pragma unroll
    for (int jt = 0; jt < 4; ++jt) { const int j = 16 * jt + r, ch = kb * 64 + j;
#pragma unroll
        for (int dir = 0; dir < 2; ++dir) {
            const float ba = p.in[8][(layer * 2 + dir) * W + ch], bx = p.in[10][(layer * 2 + dir) * W + ch], lam = p.in[11][(layer * 2 + dir) * W + ch];
            const float sp = log1pf(expf(-lam));
            float Aq = 1.f, Bq = 0.f;
#pragma unroll
            for (int s = 0; s < 4; ++s) { const int q = dir ? 3 - s : s;
                const float rg = sigm(acc[(2 * dir) * 4 + jt][q] + ba), ig = sigm(acc[(2 * dir + 1) * 4 + jt][q] + bx);
                float la = -8.0f * rg * sp; float bv = sqrtf(fmaxf(1.0f - __expf(2.0f * la), 0.f)) * ig * XCf[(tok0 + q) * 64 + j];
                if ((t0 + q) < 0) { la = 0.f; bv = 0.f; }
                const unsigned lab = f2bf(la), bvb = f2bf(bv);
                const size_t ro = (size_t)row_bci(b, c, tok0 + q) * W + ch;
                LA[(size_t)dir * MP * W + ro] = (bf16_t)lab; BB[(size_t)dir * MP * W + ro] = (bf16_t)bvb;
                const float a = __expf(__uint_as_float(lab << 16)), bq = __uint_as_float(bvb << 16);
                Bq = a * Bq + bq; Aq *= a; }
            const int g = 4 * wave + h;
            AG[((g * 2 + dir) * 2 + 0) * 64 + j] = Aq; AG[((g * 2 + dir) * 2 + 1) * 64 + j] = Bq; } }
    __syncthreads();
    if (tid < 128) { const int dir = tid >> 6, jj = tid & 63; float At = 1.f, Bt = 0.f;
        for (int s = 0; s < 32; ++s) { const int q = dir ? 31 - s : s; const float a = AG[((q * 2 + dir) * 2 + 0) * 64 + jj], bq = AG[((q * 2 + dir) * 2 + 1) * 64 + jj]; Bt = a * Bt + bq; At *= a; }
        const size_t o = (size_t)((dir * 2 + b) * NCHK + c) * W + kb * 64 + jj;
        ((float*)(p.ws + R_CA))[o] = At; ((float*)(p.ws + R_CB))[o] = Bt; }
}

__device__ __forceinline__ void lru_carry(CParams& p) {
    const int gt = blockIdx.x * 512 + opaque_tid();
    if (gt < 2048) { const int dir = gt >> 10, b = (gt >> 9) & 1, ch = gt & 511;
        const float* CA = (const float*)(p.ws + R_CA); const float* CB = (const float*)(p.ws + R_CB); float* CR = (float*)(p.ws + R_CR);
        const size_t base = (size_t)((dir * 2 + b) * NCHK) * W + ch; float h = 0.f;
        for (int s0 = 0; s0 < NCHK; s0 += 5) { float a[5], bq[5];
#pragma unroll
            for (int q = 0; q < 5; ++q) { const int c = dir ? NCHK - 1 - (s0 + q) : (s0 + q); a[q] = CA[base + (size_t)c * W]; bq[q] = CB[base + (size_t)c * W]; }
#pragma unroll
            for (int q = 0; q < 5; ++q) { const int c = dir ? NCHK - 1 - (s0 + q) : (s0 + q); CR[base + (size_t)c * W] = h; h = a[q] * h + bq[q]; } } }
}

__device__ __forceinline__ void lru_s3_item(CParams& p, int item, LAS unsigned char* lds) {
    const int cidx = item >> 3, kb = item & 7, b = cidx / NCHK, c = cidx % NCHK;
    const int tid = opaque_tid(), j = tid & 63, tq = tid >> 6, ch = kb * 64 + j;
    LAS float* AG = (LAS float*)lds;
    const bf16_t* P = (const bf16_t*)(p.ws + R_PMIX); const bf16_t* LA = (const bf16_t*)(p.ws + R_LA); const bf16_t* BB = (const bf16_t*)(p.ws + R_BB);
    bf16_t* Z = (bf16_t*)(p.ws + OFF_Z);
    float av[2][16], bv[2][16];
    size_t ro[16];
#pragma unroll
    for (int tt = 0; tt < 16; ++tt) ro[tt] = (size_t)row_bci(b, c, 16 * tq + tt);
#pragma unroll
    for (int dir = 0; dir < 2; ++dir)
#pragma unroll
        for (int tt = 0; tt < 16; ++tt) { const size_t o = (size_t)dir * MP * W + ro[tt] * W + ch; av[dir][tt] = bf2f(LA[o]); bv[dir][tt] = bf2f(BB[o]); }
    __syncthreads();
#pragma unroll
    for (int dir = 0; dir < 2; ++dir) { float Aq = 1.f, Bq = 0.f;
#pragma unroll
        for (int s = 0; s < 16; ++s) { const int tt = dir ? 15 - s : s; const float a = __expf(av[dir][tt]); av[dir][tt] = a; Bq = a * Bq + bv[dir][tt]; Aq *= a; }
        AG[((tq * 2 + dir) * 2 + 0) * 64 + j] = Aq; AG[((tq * 2 + dir) * 2 + 1) * 64 + j] = Bq; }
    __syncthreads();
    float hs[16];
#pragma unroll
    for (int dir = 0; dir < 2; ++dir) {
        float h = ((const float*)(p.ws + R_CR))[(size_t)((dir * 2 + b) * NCHK + c) * W + ch];
        for (int s = 0; s < 7; ++s) { const int q = dir ? 7 - s : s; const bool use = dir ? (q > tq) : (q < tq);
            const float a = AG[((q * 2 + dir) * 2 + 0) * 64 + j], bq = AG[((q * 2 + dir) * 2 + 1) * 64 + j]; if (use) h = a * h + bq; }
#pragma unroll
        for (int s = 0; s < 16; ++s) { const int tt = dir ? 15 - s : s; h = av[dir][tt] * h + bv[dir][tt]; if (dir == 0) hs[tt] = h; else hs[tt] += h; }
    }
#pragma unroll
    for (int tt = 0; tt < 16; ++tt) { const int i = 16 * tq + tt; const bool valid = (c * 128 + i - 112) >= 0;
        const float ga = bf2f(P[ro[tt] * NMIX + 512 + ch]);
        Z[ro[tt] * D + ch] = (bf16_t)(valid ? f2bf(hs[tt] * gelu_tanh(ga)) : 0u); }
}

__device__ __forceinline__ void conv3_16(const bf16_t* P, const float* cw, const float* cbias, int b, int t0, int col, float (&out)[16]) {
    const int cc = col - 1024; const float w0 = cw[cc], w1 = cw[1536 + cc], w2 = cw[3072 + cc], bb = cbias[cc];
    float xv[18];
#pragma unroll
    for (int q = 0; q < 18; ++q) { const int t = t0 - 1 + q; xv[q] = (t >= 0 && t < T) ? bf2f(P[(size_t)row_of(b, t) * NMIX + col]) : 0.f; }
#pragma unroll
    for (int tt = 0; tt < 16; ++tt) out[tt] = bb + w0 * xv[tt] + w1 * xv[tt + 1] + w2 * xv[tt + 2];
}

__device__ __forceinline__ void hy_s1_item(CParams& p, int layer, int item) {
    const int cidx = item >> 3, cgp = item & 7, b = cidx / NCHK, c = cidx % NCHK;
    const int tid = opaque_tid(), j = tid & 63, tq = tid >> 6, ch = cgp * 64 + j;
    const int t0 = c * 128 + 16 * tq - 112;
    if (t0 < 0) return;
    const bf16_t* P = (const bf16_t*)(p.ws + R_PMIX);
    const float* cw = p.in[12] + layer * 3 * 1536; const float* cbias = p.in[13] + layer * 1536;
    float x1[16], vv[16];
    conv3_16(P, cw, cbias, b, t0, 1024 + 512 + ch, x1); conv3_16(P, cw, cbias, b, t0, 1024 + 1024 + ch, vv);
    bf16_t* UT = (bf16_t*)(p.ws + R_UT) + ((size_t)ch * 2 + b) * TF + (t0 + FOFF);
    u32x4 wa, wb;
    wa.x = pk2(x1[0] * vv[0], x1[1] * vv[1]); wa.y = pk2(x1[2] * vv[2], x1[3] * vv[3]); wa.z = pk2(x1[4] * vv[4], x1[5] * vv[5]); wa.w = pk2(x1[6] * vv[6], x1[7] * vv[7]);
    wb.x = pk2(x1[8] * vv[8], x1[9] * vv[9]); wb.y = pk2(x1[10] * vv[10], x1[11] * vv[11]); wb.z = pk2(x1[12] * vv[12], x1[13] * vv[13]); wb.w = pk2(x1[14] * vv[14], x1[15] * vv[15]);
    *(u32x4*)UT = wa; *(u32x4*)(UT + 8) = wb;
}

__device__ __forceinline__ void hy_s3_item(CParams& p, int layer, int item) {
    const int cidx = item >> 3, cgp = item & 7, b = cidx / NCHK, c = cidx % NCHK;
    const int tid = opaque_tid(), j = tid & 63, tq = tid >> 6, ch = cgp * 64 + j;
    const int t0 = c * 128 + 16 * tq - 112;
    bf16_t* Z = (bf16_t*)(p.ws + OFF_Z);
    if (t0 < 0) {
#pragma unroll
        for (int tt = 0; tt < 16; ++tt) Z[(size_t)row_bci(b, c, 16 * tq + tt) * D + 512 + ch] = 0;
        return; }
    const bf16_t* P = (const bf16_t*)(p.ws + R_PMIX);
    const float* cw = p.in[12] + layer * 3 * 1536; const float* cbias = p.in[13] + layer * 1536;
    float x0[16];
    conv3_16(P, cw, cbias, b, t0, 1024 + ch, x0);
    const bf16_t* YT = (const bf16_t*)(p.ws + R_YT) + ((size_t)ch * 2 + b) * TF + (t0 + FOFF);
    const u32x4 ya = *(const u32x4*)YT, yb = *(const u32x4*)(YT + 8);
#pragma unroll
    for (int tt = 0; tt < 16; ++tt) { const unsigned wv = (tt < 8) ? ya[tt >> 1] : yb[(tt - 8) >> 1];
        const float y = (tt & 1) ? __uint_as_float(wv & 0xffff0000u) : __uint_as_float(wv << 16);
        Z[(size_t)row_bci(b, c, 16 * tq + tt) * D + 512 + ch] = (bf16_t)f2bf(x0[tt] * y); }
}

__device__ __forceinline__ bf16x8 toep_frag(const LAS unsigned* G32, int e) {
    const int d = e >> 1; const unsigned sh = (unsigned)(e & 1) * 16u;
    const unsigned w0 = G32[d], w1 = G32[d + 1], w2 = G32[d + 2], w3 = G32[d + 3], w4 = G32[d + 4];
    u32x4 r; r.x = __builtin_amdgcn_alignbit(w1, w0, sh); r.y = __builtin_amdgcn_alignbit(w2, w1, sh); r.z = __builtin_amdgcn_alignbit(w3, w2, sh); r.w = __builtin_amdgcn_alignbit(w4, w3, sh);
    return __builtin_bit_cast(bf16x8, r);
}

__device__ __forceinline__ bf16x8 toep_frag2(const LAS unsigned* q, unsigned sh) {
    const unsigned w0 = q[0], w1 = q[1], w2 = q[2], w3 = q[3], w4 = q[4];
    u32x4 r; r.x = __builtin_amdgcn_alignbit(w1, w0, sh); r.y = __builtin_amdgcn_alignbit(w2, w1, sh); r.z = __builtin_amdgcn_alignbit(w3, w2, sh); r.w = __builtin_amdgcn_alignbit(w4, w3, sh);
    return __builtin_bit_cast(bf16x8, r);
}

__device__ __forceinline__ void hy_conv_item(CParams& p, int layer, int ch, LAS unsigned char* lds) {
    LAS bf16_t* GRl = (LAS bf16_t*)lds; LAS bf16_t* UL = GRl + GRN; LAS float* PART = (LAS float*)(lds + GRN * 2 + 2 * UBT * 2);
    const int tid = opaque_tid(), lane = tid & 63, wave = tid >> 6, r = lane & 15, h = lane >> 4;
    const bf16_t* GRg = (const bf16_t*)(p.ws + R_GR) + (size_t)ch * GRN;
    const bf16_t* UTg = (const bf16_t*)(p.ws + R_UT) + (size_t)ch * 2 * TF;
    bf16_t* YTg = (bf16_t*)(p.ws + R_YT) + (size_t)ch * 2 * TF;
    const float bias = p.in[20][layer * W + ch];
    __syncthreads();
    for (int q = tid; q < GRN / 8; q += 512) { u32x4 v = *(const u32x4*)(GRg + q * 8);
        if (q < 254 || q >= 2306) v = (u32x4){0u, 0u, 0u, 0u}; else if (q == 254) v.x &= 0xffff0000u;
        *(LAS u32x4*)(GRl + q * 8) = v; }
    for (int q = tid; q < 2 * (TF / 8); q += 512) { const int bt = q / (TF / 8), f0 = (q % (TF / 8)) * 8;
        u32x4 v = (u32x4){0u, 0u, 0u, 0u}; if (f0 >= FOFF) v = *(const u32x4*)(UTg + (size_t)bt * TF + f0);
        *(LAS u32x4*)(UL + bt * UBT + ((f0 >> 7) + 15) * UBLK + (f0 & 127)) = v; }
    for (int q = tid; q < 2 * 30 * 17; q += 512) { const int bt = q / 510, rem = q % 510, blk = rem / 17, part = rem % 17; const int bi = blk < 15 ? blk : 65 + blk;
        *(LAS u32x4*)(UL + bt * UBT + bi * UBLK + part * 8) = (u32x4){0u, 0u, 0u, 0u}; }
    __syncthreads();
    const LAS unsigned* G32 = (const LAS unsigned*)GRl;
    { const int bt = wave >> 2, I0 = 1 + 16 * (wave & 3);
      f32x4 acc[8];
#pragma unroll
      for (int mi = 0; mi < 8; ++mi) acc[mi] = (f32x4){0.f, 0.f, 0.f, 0.f};
      const LAS bf16_t* ub = UL + bt * UBT + (I0 + r + 15) * UBLK + 8 * h;
      const int x0 = 8 * h - r + GROFF - 112;
      const unsigned sh = (unsigned)(x0 & 1) * 16u;
      const LAS unsigned* gq = G32 + (x0 >> 1) - 64 * (I0 + 15);
      const LAS bf16_t* uq = ub - (I0 + 15) * UBLK;
      bf16x8 R[16];
#pragma unroll
      for (int mm = 0; mm < 6; ++mm) R[(mm - 7) & 15] = toep_frag2(gq + 8 * mm, sh);
#define HY_STEP(PAR) { \
          _Pragma("unroll") for (int mm = 6; mm < 14; ++mm) R[(mm - 7 + 8 * (PAR)) & 15] = toep_frag2(gq + 8 * mm, sh); \
          _Pragma("unroll") for (int ks = 0; ks < 4; ++ks) { const bf16x8 B = *(const LAS bf16x8*)(uq + 32 * ks); \
              _Pragma("unroll") for (int mi = 0; mi < 8; ++mi) acc[mi] = __builtin_amdgcn_mfma_f32_16x16x32_bf16(R[(2 * ks - mi + 8 * (PAR)) & 15], B, acc[mi], 0, 0, 0); } \
          gq += 64; uq += UBLK; }
      for (int sp = 0; sp < 40; ++sp) { HY_STEP(0) HY_STEP(1) }
#undef HY_STEP
      const int I = I0 + r;
#pragma unroll
      for (int mi = 0; mi < 8; ++mi) { const int i = 16 * mi + 4 * h; const int f = 128 * I + i;
          const LAS bf16_t* up = UL + bt * UBT + (I + 15) * UBLK + i;
          u32x2 w; w.x = pk2(acc[mi][0] + bias * bf2f(up[0]), acc[mi][1] + bias * bf2f(up[1])); w.y = pk2(acc[mi][2] + bias * bf2f(up[2]), acc[mi][3] + bias * bf2f(up[3]));
          *(u32x2*)(YTg + (size_t)bt * TF + f) = w; }
    }
    if (layer == 0) { f32x4 am[8];
#pragma unroll
      for (int mi = 0; mi < 8; ++mi) am[mi] = (f32x4){0.f, 0.f, 0.f, 0.f};
      const int Lb = -64 + 8 * wave, Le = Lb + 8 + (wave == 7 ? 1 : 0);
      const int x0 = 8 * h - r + GROFF - 112; const unsigned sh = (unsigned)(x0 & 1) * 16u;
      for (int L = Lb; L < Le; ++L) {
          bf16x8 A[14];
          const LAS unsigned* gq = G32 + (x0 >> 1) - 64 * L;
#pragma unroll
          for (int mm = 0; mm < 14; ++mm) A[mm] = toep_frag2(gq + 8 * mm, sh);
#pragma unroll
          for (int ks = 0; ks < 4; ++ks) { const bf16x8 B = *(const LAS bf16x8*)(UL + (r & 1) * UBT + (15 - L) * UBLK + 32 * ks + 8 * h);
#pragma unroll
              for (int mi = 0; mi < 8; ++mi) am[mi] = __builtin_amdgcn_mfma_f32_16x16x32_bf16(A[2 * ks - mi + 7], B, am[mi], 0, 0, 0); }
      }
      if (r < 2) {
#pragma unroll
          for (int mi = 0; mi < 8; ++mi)
#pragma unroll
              for (int q = 0; q < 4; ++q) PART[(wave * 2 + r) * 128 + 16 * mi + 4 * h + q] = am[mi][q]; }
    }
    __syncthreads();
    if (layer == 0 && tid < 32) { const int bt = tid >> 4, i = 112 + (tid & 15); float s = 0.f;
#pragma unroll
        for (int w8 = 0; w8 < 8; ++w8) s += PART[(w8 * 2 + bt) * 128 + i];
        const float uu = bf2f(UL[bt * UBT + 15 * UBLK + i]); YTg[(size_t)bt * TF + i] = (bf16_t)f2bf(s + bias * uu); }
}

__device__ __forceinline__ void gla_decode(int w, int& grp, int& c) { if (w < 512) { grp = w >> 6; c = 1 + (w & 63); } else { grp = w - 512; c = 0; } }

__device__ __forceinline__ unsigned cvt_pk_bf16(float lo, float hi) { return pk2(lo, hi); }
__device__ __forceinline__ bf16x8 pack8(const f32x4 a, const f32x4 b) { u32x4 w; w.x = cvt_pk_bf16(a[0], a[1]); w.y = cvt_pk_bf16(a[2], a[3]); w.z = cvt_pk_bf16(b[0], b[1]); w.w = cvt_pk_bf16(b[2], b[3]); return __builtin_bit_cast(bf16x8, w); }
constexpr int GL_QS = 136, GL_TS = 40;
constexpr int GL_QT = 0, GL_KT = 32 * GL_QS * 2, GL_KHT = 2 * 32 * GL_QS * 2, GL_VT = GL_KHT + 128 * GL_TS * 2, GL_GS = GL_VT + 128 * GL_TS * 2, GL_HEAD = GL_GS + 512;

__device__ __forceinline__ float scan32_add(float v) {
    v += __int_as_float(__builtin_amdgcn_update_dpp(0, __float_as_int(v), 0x111, 0xf, 0xf, false));
    v += __int_as_float(__builtin_amdgcn_update_dpp(0, __float_as_int(v), 0x112, 0xf, 0xf, false));
    v += __int_as_float(__builtin_amdgcn_update_dpp(0, __float_as_int(v), 0x114, 0xf, 0xf, false));
    v += __int_as_float(__builtin_amdgcn_update_dpp(0, __float_as_int(v), 0x118, 0xf, 0xf, false));
    v += __int_as_float(__builtin_amdgcn_update_dpp(0, __float_as_int(v), 0x142, 0xa, 0xf, false));
    return v;
}
template <bool PH3>
__device__ __forceinline__ void gla_item(CParams& p, int layer, int w, LAS unsigned char* lds) {
    int grp, c; gla_decode(w, grp, c);
    const int br = grp >> 2, dir = (grp >> 1) & 1, b = grp & 1, item = grp * NCHK + c;
    const bool incl = !(br == 0 && dir == 1);
    const int tid = opaque_tid(), lane = tid & 63, wave = tid >> 6, hd = wave >> 1, vh = wave & 1, r = lane & 15, h = lane >> 4;
    LAS unsigned char* hb = lds + hd * GL_HEAD;
    const bf16_t* P = (const bf16_t*)(p.ws + R_PMIX);
    const f32x2* RT = (const f32x2*)(p.ws + OFF_ROPE);
    bf16_t* U = (bf16_t*)(p.ws + R_U) + (size_t)item * 65536 + (size_t)(hd * 128 + 4 * h) * 128 + 64 * vh + r;
    f32x4 S[8][4];
#pragma unroll
    for (int dt = 0; dt < 8; ++dt)
#pragma unroll
        for (int vt = 0; vt < 4; ++vt) {
            if (PH3) {
#pragma unroll
                for (int q = 0; q < 4; ++q) S[dt][vt][q] = bf2f(U[(16 * dt + q) * 128 + 16 * vt]);
            } else S[dt][vt] = (f32x4){0.f, 0.f, 0.f, 0.f}; }
    const int fcol = dir ? 5632 : 5120;
    bf16_t* Og = (bf16_t*)(p.ws + R_O) + (size_t)(br * 2 + dir) * MP * W;
    const int nsb = (c == 0) ? 1 : 4;
    for (int sbi = 0; sbi < nsb; ++sbi) {
        const int sb = (c == 0) ? 3 : (dir ? 3 - sbi : sbi);
        __syncthreads();
        {
            const int ip = lane & 31, hw = (lane >> 5) + 2 * wave;
            const int i = sb * 32 + (dir ? 31 - ip : ip), t = c * 128 + i - 112; const bool valid = t >= 0;
            const bf16_t* prow = P + (size_t)row_bci(b, c, i) * NMIX;
#pragma unroll 2
            for (int itc = 0; itc < 4; ++itc) {
                const int d0 = 8 * (hw + 16 * itc), shd = d0 >> 7, sdl = d0 & 127;
                LAS unsigned char* hs = lds + shd * GL_HEAD;
                float q[8], k[8], v[8], l[8];
                if (br == 0) {
                    const u32x4 kr = *(const u32x4*)(prow + 3072 + d0), kp = *(const u32x4*)(prow + 3072 + (d0 ^ 64)), vr = *(const u32x4*)(prow + 3584 + d0);
                    u32x4 qr = (u32x4){0u, 0u, 0u, 0u}, qp = (u32x4){0u, 0u, 0u, 0u};
                    if (PH3) { qr = *(const u32x4*)(prow + 2560 + d0); qp = *(const u32x4*)(prow + 2560 + (d0 ^ 64)); }
                    const f32x4* rt = (const f32x4*)(RT + (size_t)(valid ? t : 0) * 64 + (sdl & 63));
                    const f32x4 c0 = rt[0], c1 = rt[1], c2 = rt[2], c3 = rt[3];
                    const float cs[16] = {c0[0], c0[1], c0[2], c0[3], c1[0], c1[1], c1[2], c1[3], c2[0], c2[1], c2[2], c2[3], c3[0], c3[1], c3[2], c3[3]};
                    const float sgn = (sdl < 64) ? -1.f : 1.f; const float lg = log1pf(-exp2f(-5.0f - (float)shd));
#pragma unroll
                    for (int e = 0; e < 8; ++e) { const unsigned wkr = kr[e >> 1], wkp = kp[e >> 1], wvr = vr[e >> 1], wqr = qr[e >> 1], wqp = qp[e >> 1];
                        const float fkr = (e & 1) ? __uint_as_float(wkr & 0xffff0000u) : __uint_as_float(wkr << 16), fkp = (e & 1) ? __uint_as_float(wkp & 0xffff0000u) : __uint_as_float(wkp << 16);
                        const float fqr = (e & 1) ? __uint_as_float(wqr & 0xffff0000u) : __uint_as_float(wqr << 16), fqp = (e & 1) ? __uint_as_float(wqp & 0xffff0000u) : __uint_as_float(wqp << 16);
                        k[e] = (fkr * cs[2 * e] + sgn * fkp * cs[2 * e + 1]) * 0.08838834764831845f; q[e] = fqr * cs[2 * e] + sgn * fqp * cs[2 * e + 1];
                        v[e] = (e & 1) ? __uint_as_float(wvr & 0xffff0000u) : __uint_as_float(wvr << 16); l[e] = lg; }
                } else {
                    const u32x4 fr = *(const u32x4*)(prow + fcol + d0), vr = *(const u32x4*)(prow + 6144 + d0);
                    u32x4 qr = (u32x4){0u, 0u, 0u, 0u}; if (PH3) qr = *(const u32x4*)(prow + 4608 + d0);
                    const f32x4 la = *(const f32x4*)((const float*)(p.ws + OFF_LBT) + d0), lb4 = *(const f32x4*)((const float*)(p.ws + OFF_LBT) + d0 + 4);
#pragma unroll
                    for (int e = 0; e < 8; ++e) { const unsigned wfr = fr[e >> 1], wvr = vr[e >> 1], wqr = qr[e >> 1];
                        const float ffr = (e & 1) ? __uint_as_float(wfr & 0xffff0000u) : __uint_as_float(wfr << 16), fqr = (e & 1) ? __uint_as_float(wqr & 0xffff0000u) : __uint_as_float(wqr << 16);
                        const float lbv = e < 4 ? la[e & 3] : lb4[e & 3];
                        const float f = lbv + (1.0f - lbv) * sigm(ffr); l[e] = __logf(f); k[e] = 1.0f - f; q[e] = fqr * sigm(fqr);
                        v[e] = (e & 1) ? __uint_as_float(wvr & 0xffff0000u) : __uint_as_float(wvr << 16); }
                }
                if (!valid) {
#pragma unroll
                    for (int e = 0; e < 8; ++e) { q[e] = 0.f; k[e] = 0.f; v[e] = 0.f; l[e] = 0.f; } }
                float eb[8], enb[8];
                if (br == 0) {
                    const float l0 = scan32_add(l[0]); const float a0 = __expf(l0), b0 = __expf(fminf(-l0, 80.0f));
#pragma unroll
                    for (int e = 0; e < 8; ++e) { l[e] = l0; eb[e] = a0; enb[e] = b0; }
                } else {
#pragma unroll
                    for (int e = 0; e < 8; ++e) { l[e] = scan32_add(l[e]); enb[e] = __expf(fminf(-l[e], 80.0f)); eb[e] = PH3 ? __expf(l[e]) : 0.f; }
                }
                float kt[8];
#pragma unroll
                for (int e = 0; e < 8; ++e) kt[e] = k[e] * enb[e];
                LAS bf16_t* sKHT = (LAS bf16_t*)(hs + GL_KHT); LAS bf16_t* sVT = (LAS bf16_t*)(hs + GL_VT);
                if (PH3) { u32x4 wq, wk;
                    wq.x = cvt_pk_bf16(q[0] * eb[0], q[1] * eb[1]); wq.y = cvt_pk_bf16(q[2] * eb[2], q[3] * eb[3]);
                    wq.z = cvt_pk_bf16(q[4] * eb[4], q[5] * eb[5]); wq.w = cvt_pk_bf16(q[6] * eb[6], q[7] * eb[7]);
                    wk.x = cvt_pk_bf16(kt[0], kt[1]); wk.y = cvt_pk_bf16(kt[2], kt[3]); wk.z = cvt_pk_bf16(kt[4], kt[5]); wk.w = cvt_pk_bf16(kt[6], kt[7]);
                    *(LAS u32x4*)((LAS bf16_t*)(hs + GL_QT) + ip * GL_QS + sdl) = wq; *(LAS u32x4*)((LAS bf16_t*)(hs + GL_KT) + ip * GL_QS + sdl) = wk; }
#pragma unroll
                for (int e = 0; e < 8; ++e) { sKHT[(sdl + e) * GL_TS + ip] = (bf16_t)f2bf(kt[e]); sVT[(sdl + e) * GL_TS + ip] = (bf16_t)f2bf(v[e]); }
                if (ip == 31) { LAS float* sGS = (LAS float*)(hs + GL_GS); LAS float* LT = (LAS float*)(lds + 4 * GL_HEAD);
#pragma unroll
                    for (int e = 0; e < 8; ++e) { sGS[sdl + e] = __expf(l[e]); LT[d0 + e] = (sbi == 0 ? 0.f : LT[d0 + e]) + l[e]; } }
            }
        }
        __syncthreads();
        const LAS bf16_t* QT = (const LAS bf16_t*)(hb + GL_QT); const LAS bf16_t* KT = (const LAS bf16_t*)(hb + GL_KT);
        const LAS bf16_t* KHT = (const LAS bf16_t*)(hb + GL_KHT); const LAS bf16_t* VT = (const LAS bf16_t*)(hb + GL_VT); const LAS float* GS = (const LAS float*)(hb + GL_GS);
        if (PH3) {
            f32x4 X[2][2];
#pragma unroll
            for (int a = 0; a < 2; ++a)
#pragma unroll
                for (int bq = 0; bq < 2; ++bq) X[a][bq] = (f32x4){0.f, 0.f, 0.f, 0.f};
#pragma unroll
            for (int kk = 0; kk < 4; ++kk) { bf16x8 aK[2], bQ[2];
#pragma unroll
                for (int t2 = 0; t2 < 2; ++t2) { aK[t2] = *(const LAS bf16x8*)(KT + (16 * t2 + r) * GL_QS + 32 * kk + 8 * h); bQ[t2] = *(const LAS bf16x8*)(QT + (16 * t2 + r) * GL_QS + 32 * kk + 8 * h); }
#pragma unroll
                for (int jt = 0; jt < 2; ++jt)
#pragma unroll
                    for (int it = 0; it < 2; ++it) X[jt][it] = __builtin_amdgcn_mfma_f32_16x16x32_bf16(aK[jt], bQ[it], X[jt][it], 0, 0, 0); }
            bf16x8 PA[2];
#pragma unroll
            for (int it = 0; it < 2; ++it) { f32x4 lo, hi; const int ipx = 16 * it + r;
#pragma unroll
                for (int q = 0; q < 4; ++q) { const int j0 = 4 * h + q, j1 = 16 + 4 * h + q;
                    lo[q] = (incl ? (j0 <= ipx) : (j0 < ipx)) ? X[0][it][q] : 0.f; hi[q] = (incl ? (j1 <= ipx) : (j1 < ipx)) ? X[1][it][q] : 0.f; }
                PA[it] = pack8(lo, hi); }
            f32x4 O[2][4];
#pragma unroll
            for (int vt = 0; vt < 4; ++vt) { const LAS bf16_t* vp = VT + (64 * vh + 16 * vt + r) * GL_TS;
                const u32x2 lo = *(const LAS u32x2*)(vp + 4 * h), hi = *(const LAS u32x2*)(vp + 16 + 4 * h);
                const bf16x8 BV = __builtin_bit_cast(bf16x8, ((u32x4){lo.x, lo.y, hi.x, hi.y}));
#pragma unroll
                for (int it = 0; it < 2; ++it) O[it][vt] = __builtin_amdgcn_mfma_f32_16x16x32_bf16(PA[it], BV, (f32x4){0.f, 0.f, 0.f, 0.f}, 0, 0, 0); }
#pragma unroll
            for (int kk = 0; kk < 4; ++kk) { bf16x8 aQ[2];
#pragma unroll
                for (int it = 0; it < 2; ++it) { const LAS bf16_t* qp = QT + (16 * it + r) * GL_QS + 32 * kk;
                    const u32x2 lo = *(const LAS u32x2*)(qp + 4 * h), hi = *(const LAS u32x2*)(qp + 16 + 4 * h);
                    aQ[it] = __builtin_bit_cast(bf16x8, ((u32x4){lo.x, lo.y, hi.x, hi.y})); }
#pragma unroll
                for (int vt = 0; vt < 4; ++vt) { const bf16x8 BS = pack8(S[2 * kk][vt], S[2 * kk + 1][vt]);
#pragma unroll
                    for (int it = 0; it < 2; ++it) O[it][vt] = __builtin_amdgcn_mfma_f32_16x16x32_bf16(aQ[it], BS, O[it][vt], 0, 0, 0); } }
#pragma unroll
            for (int it = 0; it < 2; ++it)
#pragma unroll
                for (int q = 0; q < 4; ++q) { const int ipx = 16 * it + 4 * h + q, i = sb * 32 + (dir ? 31 - ipx : ipx);
                    if ((c * 128 + i - 112) >= 0) { bf16_t* op = Og + (size_t)row_bci(b, c, i) * W + hd * 128 + 64 * vh + r;
#pragma unroll
                        for (int vt = 0; vt < 4; ++vt) op[16 * vt] = (bf16_t)f2bf(O[it][vt][q]); } }
        }
        {
            bf16x8 bV[4];
#pragma unroll
            for (int vt = 0; vt < 4; ++vt) bV[vt] = *(const LAS bf16x8*)(VT + (64 * vh + 16 * vt + r) * GL_TS + 8 * h);
#pragma unroll
            for (int dt = 0; dt < 8; ++dt) { const f32x4 g4 = *(const LAS f32x4*)(GS + 16 * dt + 4 * h); const bf16x8 aKH = *(const LAS bf16x8*)(KHT + (16 * dt + r) * GL_TS + 8 * h);
#pragma unroll
                for (int vt = 0; vt < 4; ++vt) S[dt][vt] = __builtin_amdgcn_mfma_f32_16x16x32_bf16(aKH, bV[vt], S[dt][vt], 0, 0, 0) * g4; }
        }
    }
    if (!PH3) {
#pragma unroll
        for (int dt = 0; dt < 8; ++dt)
#pragma unroll
            for (int vt = 0; vt < 4; ++vt)
#pragma unroll
                for (int q = 0; q < 4; ++q) U[(16 * dt + q) * 128 + 16 * vt] = (bf16_t)f2bf(S[dt][vt][q]);
        __syncthreads();
        ((float*)(p.ws + R_GG))[(size_t)item * 512 + tid] = __expf(((const LAS float*)(lds + 4 * GL_HEAD))[tid]);
    }
}

__device__ __forceinline__ void gla_carry(CParams& p) {
    const int gidx = blockIdx.x * 512 + opaque_tid();
    if (gidx >= 8 * 16384) return;
    const int grp = gidx >> 14, e4 = gidx & 16383, dir = (grp >> 1) & 1, hdd = (e4 * 4) >> 7;
    bf16_t* U = (bf16_t*)(p.ws + R_U) + (size_t)grp * NCHK * 65536 + e4 * 4; const float* GG = (const float*)(p.ws + R_GG) + (size_t)grp * NCHK * 512 + hdd;
    f32x4 S = (f32x4){0.f, 0.f, 0.f, 0.f};
    for (int s0 = 0; s0 < NCHK; s0 += 5) {
        u32x2 u[5]; float g[5];
#pragma unroll
        for (int q = 0; q < 5; ++q) { const int c = dir ? NCHK - 1 - (s0 + q) : (s0 + q); u[q] = *(const u32x2*)(U + (size_t)c * 65536); g[q] = GG[(size_t)c * 512]; }
#pragma unroll
        for (int q = 0; q < 5; ++q) { const int c = dir ? NCHK - 1 - (s0 + q) : (s0 + q);
            u32x2 w; w.x = pk2(S[0], S[1]); w.y = pk2(S[2], S[3]); *(u32x2*)(U + (size_t)c * 65536) = w;
            const f32x4 uv = (f32x4){__uint_as_float(u[q].x << 16), __uint_as_float(u[q].x & 0xffff0000u), __uint_as_float(u[q].y << 16), __uint_as_float(u[q].y & 0xffff0000u)};
            S = S * g[q] + uv; }
    }
}

__device__ __forceinline__ void gla_s4(CParams& p) {
    const int tid0 = opaque_tid(); const int lane = tid0 & 63, gw = blockIdx.x * 8 + (tid0 >> 6), NW = gridDim.x * 8;
    const bf16_t* P = (const bf16_t*)(p.ws + R_PMIX); const bf16_t* O = (const bf16_t*)(p.ws + R_O); bf16_t* Z = (bf16_t*)(p.ws + OFF_Z);
    for (int it = gw; it < MP * 2; it += NW) { const int row = it >> 1, br = it & 1;
        bf16_t* zp = Z + (size_t)row * D + 1024 + br * W + lane * 8;
        if (row >= MX && ((row - MX) & 127) < 112) { *(u32x4*)zp = (u32x4){0u, 0u, 0u, 0u}; continue; }
        const u32x4 of = *(const u32x4*)(O + ((size_t)(br * 2 + 0) * MP + row) * W + lane * 8), ob = *(const u32x4*)(O + ((size_t)(br * 2 + 1) * MP + row) * W + lane * 8);
        const u32x4 gv = *(const u32x4*)(P + (size_t)row * NMIX + (br ? 6656 : 4096) + lane * 8);
        float o[8], g[8];
#pragma unroll
        for (int q = 0; q < 4; ++q) { o[2 * q] = __uint_as_float(of[q] << 16) + __uint_as_float(ob[q] << 16); o[2 * q + 1] = __uint_as_float(of[q] & 0xffff0000u) + __uint_as_float(ob[q] & 0xffff0000u);
            g[2 * q] = __uint_as_float(gv[q] << 16); g[2 * q + 1] = __uint_as_float(gv[q] & 0xffff0000u); }
        float s = 0.f;
#pragma unroll
        for (int q = 0; q < 8; ++q) s += o[q];
        s += __shfl_xor(s, 1); s += __shfl_xor(s, 2); s += __shfl_xor(s, 4); s += __shfl_xor(s, 8);
        const float mu = br ? 0.f : s * (1.0f / 128.0f);
        float s2 = 0.f;
#pragma unroll
        for (int q = 0; q < 8; ++q) { o[q] -= mu; s2 += o[q] * o[q]; }
        s2 += __shfl_xor(s2, 1); s2 += __shfl_xor(s2, 2); s2 += __shfl_xor(s2, 4); s2 += __shfl_xor(s2, 8);
        const float rs = 1.0f / sqrtf(s2 * (1.0f / 128.0f) + EPS);
        u32x4 w;
#pragma unroll
        for (int q = 0; q < 4; ++q) w[q] = pk2(o[2 * q] * rs * siluf(g[2 * q]), o[2 * q + 1] * rs * siluf(g[2 * q + 1]));
        *(u32x4*)zp = w; }
}


__device__ __forceinline__ void skinny_acc(const bf16_t* A, int lda, const bf16_t* Wrow, int ldw, int k_begin, int nk, int r, int h, f32x4 (&acc)[2]) {
    const bf16_t* a0 = A + (size_t)(MX + 112 + r) * lda + 8 * h + k_begin;
    const bf16_t* a1 = A + (size_t)(MX + 128 + 112 + r) * lda + 8 * h + k_begin;
    const bf16_t* bp = Wrow + (size_t)r * ldw + 8 * h + k_begin;
#pragma unroll 8
    for (int ks = 0; ks < nk; ++ks) { const bf16x8 x0 = *(const bf16x8*)(a0 + 32 * ks), x1 = *(const bf16x8*)(a1 + 32 * ks), bb = *(const bf16x8*)(bp + 32 * ks);
        acc[0] = __builtin_amdgcn_mfma_f32_16x16x32_bf16(x0, bb, acc[0], 0, 0, 0); acc[1] = __builtin_amdgcn_mfma_f32_16x16x32_bf16(x1, bb, acc[1], 0, 0, 0); }
}
#define SK_HEAD const int tid = opaque_tid(), lane = tid & 63, wave = tid >> 6, r = lane & 15, h = lane >> 4; LAS float* part = (LAS float*)lds; \
    const int e_mt = tid >> 8, e_q = (tid >> 6) & 3, e_h = (tid & 63) >> 4, e_r = tid & 15; const size_t e_row = (size_t)(MX + 128 * e_mt + 112 + 4 * e_h + e_q);
__device__ __forceinline__ void sk_put(LAS float* part, int wave, int lane, const f32x4 (&acc)[2]) {
#pragma unroll
    for (int mt = 0; mt < 2; ++mt)
#pragma unroll
        for (int q = 0; q < 4; ++q) part[wave * 512 + (mt * 4 + q) * 64 + lane] = acc[mt][q];
}
__device__ __forceinline__ float sk_sum8(const LAS float* part, int tid) { float s = 0.f;
#pragma unroll
    for (int w8 = 0; w8 < 8; ++w8) s += part[w8 * 512 + tid];
    return s; }
__device__ __forceinline__ void skinny_in(CParams& p, int mode, LAS unsigned char* lds) {
    SK_HEAD
    const bf16_t* NB = (const bf16_t*)(p.ws + OFF_NB); const bf16_t* WIN = (const bf16_t*)(p.ws + OFF_WIN) + (size_t)(mode ? NMIX : 0) * D;
    const int ntile = mode ? NGATE / 16 : NMIX / 16;
    for (int t0 = blockIdx.x; t0 < ntile; t0 += 2 * gridDim.x) { const int t1 = t0 + gridDim.x; const bool two = t1 < ntile; const int t1c = two ? t1 : t0;
        f32x4 aA[2] = {(f32x4){0.f, 0.f, 0.f, 0.f}, (f32x4){0.f, 0.f, 0.f, 0.f}}, aB[2] = {(f32x4){0.f, 0.f, 0.f, 0.f}, (f32x4){0.f, 0.f, 0.f, 0.f}};
        __syncthreads();
        { const int kb = wave * (D / 8);
          const bf16_t* a0 = NB + (size_t)(MX + 112 + r) * D + 8 * h + kb; const bf16_t* a1 = NB + (size_t)(MX + 128 + 112 + r) * D + 8 * h + kb;
          const bf16_t* b0 = WIN + (size_t)(t0 * 16 + r) * D + 8 * h + kb; const bf16_t* b1 = WIN + (size_t)(t1c * 16 + r) * D + 8 * h + kb;
#pragma unroll
          for (int ks = 0; ks < D / 256; ++ks) { const bf16x8 x0 = *(const bf16x8*)(a0 + 32 * ks), x1 = *(const bf16x8*)(a1 + 32 * ks), w0 = *(const bf16x8*)(b0 + 32 * ks), w1 = *(const bf16x8*)(b1 + 32 * ks);
              aA[0] = __builtin_amdgcn_mfma_f32_16x16x32_bf16(x0, w0, aA[0], 0, 0, 0); aA[1] = __builtin_amdgcn_mfma_f32_16x16x32_bf16(x1, w0, aA[1], 0, 0, 0);
              aB[0] = __builtin_amdgcn_mfma_f32_16x16x32_bf16(x0, w1, aB[0], 0, 0, 0); aB[1] = __builtin_amdgcn_mfma_f32_16x16x32_bf16(x1, w1, aB[1], 0, 0, 0); } }
        sk_put(part, wave, lane, aA); sk_put(part + 4096, wave, lane, aB);
        __syncthreads();
        const float sA = sk_sum8(part, tid), sB = sk_sum8(part + 4096, tid);
        if (mode) { bf16_t* G = (bf16_t*)(p.ws + R_G); G[e_row * NGATE + t0 * 16 + e_r] = (bf16_t)f2bf(sA); if (two) G[e_row * NGATE + t1 * 16 + e_r] = (bf16_t)f2bf(sB); }
        else { bf16_t* P = (bf16_t*)(p.ws + R_PMIX); P[e_row * NMIX + t0 * 16 + e_r] = (bf16_t)f2bf(sA); if (two) P[e_row * NMIX + t1 * 16 + e_r] = (bf16_t)f2bf(sB); } }
}
__device__ __forceinline__ void skinny_branch(CParams& p, LAS unsigned char* lds) {
    SK_HEAD
    const bf16_t* Z = (const bf16_t*)(p.ws + OFF_Z); const bf16_t* WBO = (const bf16_t*)(p.ws + OFF_WBO); const bf16_t* G = (const bf16_t*)(p.ws + R_G); bf16_t* MB = (bf16_t*)(p.ws + R_MB);
    const int z = wave >> 1, kh = wave & 1;
    for (int tile = blockIdx.x; tile < D / 16; tile += gridDim.x) { f32x4 acc[2] = {(f32x4){0.f, 0.f, 0.f, 0.f}, (f32x4){0.f, 0.f, 0.f, 0.f}};
        __syncthreads();
        skinny_acc(Z + z * W, D, WBO + (size_t)z * D * W + (size_t)tile * 16 * W, W, kh * (W / 2), W / 64, r, h, acc);
        sk_put(part, wave, lane, acc);
        __syncthreads();
        float tot = 0.f;
#pragma unroll
        for (int zz = 0; zz < 4; ++zz) tot += sigm(bf2f(G[e_row * NGATE + zz * D + tile * 16 + e_r])) * (part[(2 * zz) * 512 + tid] + part[(2 * zz + 1) * 512 + tid]);
        MB[e_row * D + tile * 16 + e_r] = (bf16_t)f2bf(tot); }
}
__device__ __forceinline__ void skinny_resid(CParams& p, const bf16_t* A, int lda, const bf16_t* Wt, int K, LAS unsigned char* lds) {
    SK_HEAD
    float* H = (float*)(p.ws + OFF_H);
    for (int tile = blockIdx.x; tile < D / 16; tile += gridDim.x) { f32x4 acc[2] = {(f32x4){0.f, 0.f, 0.f, 0.f}, (f32x4){0.f, 0.f, 0.f, 0.f}};
        __syncthreads();
        skinny_acc(A, lda, Wt + (size_t)tile * 16 * K, K, wave * (K / 8), K / 256, r, h, acc);
        sk_put(part, wave, lane, acc);
        __syncthreads();
        H[e_row * D + tile * 16 + e_r] += sk_sum8(part, tid); }
}
__device__ __forceinline__ void skinny_swiglu(CParams& p, LAS unsigned char* lds) {
    SK_HEAD
    const bf16_t* NB = (const bf16_t*)(p.ws + OFF_NB); const bf16_t* WGU = (const bf16_t*)(p.ws + OFF_WGU); bf16_t* FF = (bf16_t*)(p.ws + R_FF);
    for (int tile = blockIdx.x; tile < DFF / 16; tile += gridDim.x) { const int c0 = tile * 16, wr0 = 256 * (c0 >> 7) + (c0 & 127);
        f32x4 ag[2] = {(f32x4){0.f, 0.f, 0.f, 0.f}, (f32x4){0.f, 0.f, 0.f, 0.f}}, au[2] = {(f32x4){0.f, 0.f, 0.f, 0.f}, (f32x4){0.f, 0.f, 0.f, 0.f}};
        __syncthreads();
        { const int kb = wave * (D / 8);
          const bf16_t* a0 = NB + (size_t)(MX + 112 + r) * D + 8 * h + kb; const bf16_t* a1 = NB + (size_t)(MX + 128 + 112 + r) * D + 8 * h + kb;
          const bf16_t* bg = WGU + (size_t)(wr0 + r) * D + 8 * h + kb; const bf16_t* bu = WGU + (size_t)(wr0 + 128 + r) * D + 8 * h + kb;
#pragma unroll
          for (int ks = 0; ks < D / 256; ++ks) { const bf16x8 x0 = *(const bf16x8*)(a0 + 32 * ks), x1 = *(const bf16x8*)(a1 + 32 * ks), wg = *(const bf16x8*)(bg + 32 * ks), wu = *(const bf16x8*)(bu + 32 * ks);
              ag[0] = __builtin_amdgcn_mfma_f32_16x16x32_bf16(x0, wg, ag[0], 0, 0, 0); ag[1] = __builtin_amdgcn_mfma_f32_16x16x32_bf16(x1, wg, ag[1], 0, 0, 0);
              au[0] = __builtin_amdgcn_mfma_f32_16x16x32_bf16(x0, wu, au[0], 0, 0, 0); au[1] = __builtin_amdgcn_mfma_f32_16x16x32_bf16(x1, wu, au[1], 0, 0, 0); } }
        sk_put(part, wave, lane, ag); sk_put(part + 4096, wave, lane, au);
        __syncthreads();
        const float g = sk_sum8(part, tid), u = sk_sum8(part + 4096, tid);
        FF[e_row * DFF + c0 + e_r] = (bf16_t)f2bf(siluf(g) * u); }
}


#define XB_TMO      128
#define XB_XCNT(j)  (256  + 64 * (j))
#define XB_XSUB(j)  (1280 + 64 * (j))
#define XB_XGEN(j)  (2304 + 64 * (j))
#define XB_TOP      3328
#define XB_TOPGEN   3392
#define XCD_BAR_WORDS 3456
#define XB_SPIN_CAP (1u << 22)
__device__ __forceinline__ unsigned xb_ld(unsigned* p)              { return __hip_atomic_load(p, __ATOMIC_RELAXED, __HIP_MEMORY_SCOPE_AGENT); }
__device__ __forceinline__ unsigned xb_add(unsigned* p, unsigned v) { return __hip_atomic_fetch_add(p, v, __ATOMIC_RELAXED, __HIP_MEMORY_SCOPE_AGENT); }
__device__ __forceinline__ unsigned xb_xcc_id() { return (unsigned)__builtin_amdgcn_s_getreg((3 << 11) | 20) & 0xFu; }
#define XB_SPIN(cond, bar) do { unsigned _sp = 0; while (cond) { __builtin_amdgcn_s_sleep(1); \
    if ((++_sp & 255u) == 0u) { if (xb_ld(&(bar)[XB_TMO])) break; if (_sp > XB_SPIN_CAP) { atomicAdd(&(bar)[XB_TMO], 1u); break; } } } } while (0)
struct XcdBarrier { unsigned* bar; unsigned x; volatile LAS unsigned* st; };
__device__ __forceinline__ XcdBarrier xcd_barrier_post(unsigned* bar, volatile LAS unsigned* st) {
    XcdBarrier b; b.bar = bar; b.x = xb_xcc_id(); b.st = st;
    if (threadIdx.x == 0) (void)xb_add(&bar[XB_XCNT(b.x)], 1u);
    return b;
}
__device__ __forceinline__ void xcd_barrier_complete(unsigned* bar, unsigned x, unsigned& nloc, unsigned& nx) {
    const unsigned G = gridDim.x * gridDim.y * gridDim.z;
    unsigned sum, cnt, mine, sp = 0u;
    for (;;) {
        sum = 0u; cnt = 0u; mine = 0u;
#pragma unroll
        for (unsigned j = 0; j < 16; ++j) { const unsigned c = xb_ld(&bar[XB_XCNT(j)]); sum += c; cnt += (c > 0u) ? 1u : 0u; mine = (j == x) ? c : mine; }
        if (sum == G) break;
        __builtin_amdgcn_s_sleep(1);
        if ((++sp & 255u) == 0u) { if (xb_ld(&bar[XB_TMO])) break; if (sp > XB_SPIN_CAP) { atomicAdd(&bar[XB_TMO], 1u); break; } }
    }
    nloc = mine > 0u ? mine : 1u; nx = cnt > 0u ? cnt : 1u;
}
__device__ __forceinline__ void xcd_barrier(const XcdBarrier& b) {
    asm volatile("s_waitcnt vmcnt(0)" ::: "memory");
    __syncthreads();
    if (threadIdx.x == 0) {
        unsigned* bar = b.bar;
        __builtin_amdgcn_s_waitcnt(0);
        unsigned nloc = b.st[0], nx = b.st[1];
        if (nloc == 0u) { xcd_barrier_complete(bar, b.x, nloc, nx); b.st[0] = nloc; b.st[1] = nx; }
        const unsigned old = xb_add(&bar[XB_XSUB(b.x)], 1u);
        const unsigned gen = old / nloc;
        if (old + 1u == (gen + 1u) * nloc) {
            __builtin_amdgcn_fence(__ATOMIC_RELEASE, "agent");
            asm volatile("s_waitcnt vmcnt(0)" ::: "memory");
            const unsigned og = xb_add(&bar[XB_TOP], 1u);
            const unsigned tg = og / nx;
            if (og + 1u == (tg + 1u) * nx) xb_add(&bar[XB_TOPGEN], 1u);
            else XB_SPIN(xb_ld(&bar[XB_TOPGEN]) == tg, bar);
            __builtin_amdgcn_fence(__ATOMIC_ACQUIRE, "agent");
            xb_add(&bar[XB_XGEN(b.x)], 1u);
            asm volatile("s_waitcnt vmcnt(0)" ::: "memory");
        } else {
            XB_SPIN(xb_ld(&bar[XB_XGEN(b.x)]) == gen, bar);
            __builtin_amdgcn_fence(__ATOMIC_ACQUIRE, "agent");
            asm volatile("s_waitcnt vmcnt(0)" ::: "memory");
        }
    }
    __syncthreads();
}

#ifndef WG_A
#define WG_A 4
#endif
#ifndef WG_N8
#define WG_N8 4
#endif
#ifndef PH_MASK
#define PH_MASK 0xFFFFFFF
#endif
#ifndef REP_MASK
#define REP_MASK 0
#endif
#define PH(n) for (int _r = 0, _n = 1 + ((p.rep >> (n)) & 1); _r < _n; ++_r) if (PH_MASK & (1 << (n)))
__device__ __forceinline__ CParams* kparams() { CParams* q = (CParams*)__builtin_amdgcn_kernarg_segment_ptr(); asm volatile("" : "+s"(q)); return q; }
#define p (*kparams())
__global__ void __launch_bounds__(512, 2) mega(Params p_unused) {
    extern __shared__ __attribute__((aligned(16))) unsigned char lds_raw[];
    LAS unsigned char* lds = (LAS unsigned char*)lds_raw;
    cg::grid_group grid = cg::this_grid();
    const int G = gridDim.x, bx = blockIdx.x;
    volatile LAS unsigned* xst = (volatile LAS unsigned*)(lds + 157680);
    if (threadIdx.x == 0) { xst[0] = 0u; xst[1] = 0u; }
    __syncthreads();
    const XcdBarrier xb = xcd_barrier_post((unsigned*)(p.ws + OFF_BAR), xst);
#pragma unroll 1
    for (int layer = 0; layer < 2; ++layer) {
        PH(0) phase_prep(p, layer, lds);
        if (layer == 0) grid.sync(); else xcd_barrier(xb);
        PH(1) { pg8::PlainSched S{MX / 256, NMIX / 256, G, bx, (const char*)(p.ws + OFF_NB), (const char*)(p.ws + OFF_WIN), (size_t)256 * D * 2, (size_t)256 * D * 2, WG_A};
          pg8::EpiBf16<0> E{(bf16_t*)(p.ws + R_PMIX), NMIX};
          pg8::gemm_phase(lds, D, D, D, S, E); }
        PH(18) skinny_in(p, 0, lds);
        xcd_barrier(xb);
        PH(2) for (int it = bx; it < 520; it += G) gla_item<false>(p, layer, it, lds);
        PH(3) for (int it = (G == 256 ? (bx ^ 128) : bx); it < 1040; it += G) lru_s1_item(p, layer, it, lds);
        PH(4) for (int it = (G == 256 ? (bx ^ 64) : bx); it < 1040; it += G) hy_s1_item(p, layer, it);
        xcd_barrier(xb);
        PH(5) for (int ch = bx; ch < W; ch += G) hy_conv_item(p, layer, ch, lds);
        PH(6) lru_carry(p);
        PH(6) gla_carry(p);
        xcd_barrier(xb);
        PH(7) for (int it = bx; it < 520; it += G) gla_item<true>(p, layer, it, lds);
        PH(8) for (int it = (G == 256 ? (bx ^ 128) : bx); it < 1040; it += G) lru_s3_item(p, it, lds);
        PH(9) for (int it = (G == 256 ? (bx ^ 64) : bx); it < 1040; it += G) hy_s3_item(p, layer, it);
        xcd_barrier(xb);
        PH(10) gla_s4(p);
        __syncthreads();
        PH(11) { pg8::PlainSched S{MX / 256, NGATE / 256, G, bx, (const char*)(p.ws + OFF_NB), (const char*)(p.ws + OFF_WIN) + (size_t)NMIX * D * 2, (size_t)256 * D * 2, (size_t)256 * D * 2, WG_A};
          pg8::EpiBf16<0> E{(bf16_t*)(p.ws + R_G), NGATE};
          pg8::gemm_phase(lds, D, D, D, S, E); }
        if (layer == 0) { PH(19) skinny_in(p, 1, lds); }
        xcd_barrier(xb);
        PH(12) { pg8::BranchSched S{MX / 256, D / 256, G, bx, (const char*)(p.ws + OFF_Z), (const char*)(p.ws + OFF_WBO), (size_t)256 * D * 2, (size_t)256 * W * 2, WG_N8};
          pg8::EpiBranch E{(bf16_t*)(p.ws + R_MB), (const bf16_t*)(p.ws + R_G)};
          pg8::gemm_phase(lds, D, W, W, S, E); }
        if (layer == 0) { PH(20) skinny_branch(p, lds); }
        xcd_barrier(xb);
        PH(13) { pg8::PlainSched S{MX / 256, D / 256, G, bx, (const char*)(p.ws + R_MB), (const char*)(p.ws + OFF_WOUT), (size_t)256 * D * 2, (size_t)256 * D * 2, WG_N8};
          pg8::EpiResid E{(float*)(p.ws + OFF_H), layer == 0 ? p.in[0] : (const float*)(p.ws + OFF_H)};
          pg8::gemm_phase(lds, D, D, D, S, E); }
        if (layer == 0) { PH(21) skinny_resid(p, (const bf16_t*)(p.ws + R_MB), D, (const bf16_t*)(p.ws + OFF_WOUT), D, lds); }
        xcd_barrier(xb);
        PH(14) norm_rows(p, 1, p.in[3] + layer * D, layer == 0 ? MP : MX);
        xcd_barrier(xb);
        PH(15) { pg8::PlainSched S{MX / 256, 2 * DFF / 256, G, bx, (const char*)(p.ws + OFF_NB), (const char*)(p.ws + OFF_WGU), (size_t)256 * D * 2, (size_t)256 * D * 2, 16};
          pg8::EpiSwiglu E{(bf16_t*)(p.ws + R_FF)};
          pg8::gemm_phase(lds, D, D, D, S, E); }
        if (layer == 0) { PH(22) skinny_swiglu(p, lds); }
        xcd_barrier(xb);
        PH(16) { pg8::PlainSched S{MX / 256, D / 256, G, bx, (const char*)(p.ws + R_FF), (const char*)(p.ws + OFF_WD), (size_t)256 * DFF * 2, (size_t)256 * DFF * 2, WG_N8};
          pg8::EpiResid E{(float*)(p.ws + OFF_H), (const float*)(p.ws + OFF_H)};
          pg8::gemm_phase(lds, DFF, DFF, DFF, S, E); }
        if (layer == 0) { PH(23) skinny_resid(p, (const bf16_t*)(p.ws + R_FF), DFF, (const bf16_t*)(p.ws + OFF_WD), DFF, lds); }
        xcd_barrier(xb);
    }
    PH(17) norm_rows(p, 3, p.in[27], MX);
}

#undef p
extern "C" void kernel_launch(void* const* d_in, const int* in_sizes, int n_in, void* d_out, int out_size,
                              void* d_ws, size_t ws_size, hipStream_t stream) {
    constexpr size_t kLds = 157696;
    static int grid_blocks = 0;
    if (!grid_blocks) {
        int dev = 0, cus = 0, per_cu = 0;
        hipGetDevice(&dev);
        hipDeviceGetAttribute(&cus, hipDeviceAttributeMultiprocessorCount, dev);
        hipFuncSetAttribute((const void*)mega, hipFuncAttributeMaxDynamicSharedMemorySize, (int)kLds);
        hipOccupancyMaxActiveBlocksPerMultiprocessor(&per_cu, (const void*)mega, 512, kLds);
        if (per_cu < 1) per_cu = 1;
        grid_blocks = cus * per_cu;
        if (ws_size < WS_TOTAL || n_in != 28) { fprintf(stderr, "kernel_launch: workspace %zu < %zu or n_in %d != 28\n", ws_size, (size_t)WS_NEED, n_in); grid_blocks = -1; }
    }
    if (grid_blocks < 0) return;
    if (hipMemsetAsync((char*)d_ws + OFF_BAR, 0, 16384, stream) != hipSuccess) { fprintf(stderr, "kernel_launch: memset failed\n"); return; }
    Params p{};
    for (int i = 0; i < 28; ++i) p.in[i] = (const float*)d_in[i];
    p.out = (float*)d_out; p.ws = (unsigned char*)d_ws; p.rep = REP_MASK; p.pad = 0;
    void* args[] = {&p};
    hipError_t e = hipLaunchCooperativeKernel((void*)mega, dim3(grid_blocks), dim3(512), args, kLds, stream);
    if (e != hipSuccess) fprintf(stderr, "cooperative launch failed: %s (grid %d)\n", hipGetErrorString(e), grid_blocks);
}
```

```cpp
#include <hip/hip_runtime.h>
#include <hip/hip_cooperative_groups.h>
#include <cstdio>
namespace cg = cooperative_groups;

#define LAS __attribute__((address_space(3)))
typedef unsigned short bf16_t;
typedef short bf16x8 __attribute__((ext_vector_type(8)));
typedef float f32x4 __attribute__((ext_vector_type(4)));
typedef float f32x2 __attribute__((ext_vector_type(2)));
typedef unsigned u32x4 __attribute__((ext_vector_type(4)));
typedef unsigned u32x2 __attribute__((ext_vector_type(2)));

constexpr int D = 2048, T = 8208, SEQ = 8192, W = 512, MP = 16640, MX = 16384, NMIX = 7168, NGATE = 8192, DFF = 5632, NCHK = 65;
constexpr int GRN = 18576, GROFF = 10240, UBLK = 136, UBT = 95 * 136, TF = 8320, FOFF = 112;
constexpr float EPS = 1e-6f;

constexpr size_t OFF_H = 0;
constexpr size_t OFF_NB = OFF_H + (size_t)MP * D * 4;
constexpr size_t OFF_Z = OFF_NB + (size_t)MP * D * 2;
constexpr size_t OFF_WIN = OFF_Z + (size_t)MP * D * 2;
constexpr size_t OFF_WBO = OFF_WIN + (size_t)15360 * 2048 * 2;
constexpr size_t OFF_WOUT = OFF_WBO + (size_t)4 * 2048 * 512 * 2;
constexpr size_t OFF_WGU = OFF_WOUT + (size_t)2048 * 2048 * 2;
constexpr size_t OFF_WD = OFF_WGU + (size_t)11264 * 2048 * 2;
constexpr size_t OFF_ROPE = OFF_WD + (size_t)2048 * 5632 * 2;
constexpr size_t OFF_R = OFF_ROPE + (size_t)T * 64 * 8;
constexpr size_t R_PMIX = OFF_R;
constexpr size_t R_O = R_PMIX + (size_t)MP * NMIX * 2;
constexpr size_t R_LA = R_O + (size_t)4 * MP * W * 2;
constexpr size_t R_BB = R_LA + (size_t)2 * MP * W * 2;
constexpr size_t R_U = R_BB + (size_t)2 * MP * W * 2;
constexpr size_t R_GG = R_U + (size_t)520 * 65536 * 4;
constexpr size_t R_UT = R_GG + (size_t)520 * 512 * 4;
constexpr size_t R_GR = R_UT + (size_t)512 * 2 * TF * 2;
constexpr size_t R_CA = R_GR + (size_t)512 * GRN * 2;
constexpr size_t R_CB = R_CA + (size_t)4 * 65 * 512 * 4;
constexpr size_t R_CR = R_CB + (size_t)4 * 65 * 512 * 4;
constexpr size_t R_YT = R_CR + (size_t)4 * 65 * 512 * 4;
constexpr size_t R_END1 = R_YT + (size_t)512 * 2 * TF * 2;
constexpr size_t R_G = R_LA;
constexpr size_t R_MB = OFF_R;
constexpr size_t R_FF = OFF_R + (size_t)MP * D * 2;
constexpr size_t WS_NEED = (R_G + (size_t)MP * NGATE * 2) > R_END1 ? (R_G + (size_t)MP * NGATE * 2) : R_END1;
static_assert(R_END1 <= WS_NEED, "scratch");
constexpr size_t OFF_BAR = (WS_NEED + 255) & ~(size_t)255;
constexpr size_t OFF_LRUW = OFF_BAR + 16384;
constexpr size_t OFF_LBT = OFF_LRUW + 262144;
constexpr size_t WS_TOTAL = OFF_LBT + 2048;
static_assert(WS_TOTAL <= (size_t)1006632960, "workspace too large");
static_assert(R_FF + (size_t)MP * DFF * 2 <= WS_NEED, "ff");

struct Params { const float* in[28]; float* out; unsigned char* ws; int rep; int pad; };
typedef const __attribute__((address_space(4))) Params CParams;

__device__ __forceinline__ float bf2f(bf16_t b) { return __uint_as_float(((unsigned)b) << 16); }
typedef __bf16 bf16v2 __attribute__((ext_vector_type(2)));
__device__ __forceinline__ unsigned pk2(float lo, float hi) { const f32x2 v = {lo, hi}; const bf16v2 b = __builtin_convertvector(v, bf16v2); return __builtin_bit_cast(unsigned, b); }
__device__ __forceinline__ unsigned f2bf(float f) { return pk2(f, 0.f) & 0xffffu; }
__device__ __forceinline__ float sigm(float x) { return __builtin_amdgcn_rcpf(1.0f + __expf(-x)); }
__device__ __forceinline__ float siluf(float x) { return x * sigm(x); }
__device__ __forceinline__ float gelu_tanh(float x) { return 0.5f * x * (1.0f + tanhf(0.7978845608028654f * (x + 0.044715f * x * x * x))); }
__device__ __forceinline__ int row_of(int b, int t) { return t < 16 ? (MX + b * 128 + 112 + t) : (b * SEQ + (t - 16)); }
__device__ __forceinline__ int row_bci(int b, int c, int i) { return c == 0 ? (MX + b * 128 + i) : (b * SEQ + (c - 1) * 128 + i); }
__device__ __forceinline__ int opaque_tid() { int t = threadIdx.x; asm volatile("" : "+v"(t)); return t; }
#define LDS_WAIT() asm volatile("s_waitcnt lgkmcnt(0)" ::: "memory")

namespace pg8 {
constexpr int BM = 256, BK = 64, HALF = 128, HTB = HALF * BK * 2, NXCD = 8, WGM = 8;
__device__ __forceinline__ int lds_byte(int r, int c) { const int st = (r >> 4) * 2 + (c >> 5), rr = r & 15, cc = c & 31, ob = rr * 64 + cc * 2; return st * 1024 + (ob ^ (((ob >> 9) & 1) << 5)); }
__device__ __forceinline__ void stage_rc(int b, int& R, int& C) { const int st = b / 1024, sb = b % 1024, swz = sb ^ (((sb >> 9) & 1) << 5); R = (st >> 1) * 16 + swz / 64; C = (st & 1) * 32 + (swz % 64) / 2; }
__device__ __forceinline__ int perm32(int rho) { const int n = rho >> 4, i = rho & 15; return 8 * (i >> 2) + 4 * n + (i & 3); }
struct Unit { int pm, pn, z; };
__device__ __forceinline__ bool tile_of(long L, int nM, int nN, int WGMr, int& pm, int& pn) {
    const int nwg = nM * nN; if (L >= nwg) return false;
    int wgid = (int)L; { const int q = nwg / NXCD, r = nwg % NXCD, xcd = wgid % NXCD, off = wgid / NXCD; wgid = (xcd < r ? xcd * (q + 1) : r * (q + 1) + (xcd - r) * q) + off; }
    const int nig = WGMr * nN, gid = wgid / nig, fm = gid * WGMr, gsz = (nM - fm) < WGMr ? (nM - fm) : WGMr;
    pm = fm + ((wgid % nig) % gsz); pn = (wgid % nig) / gsz; return true;
}
struct PlainSched {
    int nM, nN, G, c; const char* A; const char* B; size_t at, bt; int wgm;
    __device__ __forceinline__ bool next(int i, Unit& u) const { u.z = 0; return tile_of((long)i * G + c, nM, nN, wgm, u.pm, u.pn); }
    __device__ __forceinline__ const char* aptr(const Unit& u) const { return A + (size_t)u.pm * at; }
    __device__ __forceinline__ const char* bptr(const Unit& u) const { return B + (size_t)u.pn * bt; }
};
struct BranchSched {
    int nM, nN, G, c; const char* A; const char* B; size_t at, bt; int wgm;
    __device__ __forceinline__ bool next(int i, Unit& u) const { u.z = i & 3; return tile_of((long)(i >> 2) * G + c, nM, nN, wgm, u.pm, u.pn); }
    __device__ __forceinline__ const char* aptr(const Unit& u) const { return A + (size_t)u.pm * at + (size_t)u.z * (W * 2); }
    __device__ __forceinline__ const char* bptr(const Unit& u) const { return B + (size_t)u.z * ((size_t)D * W * 2) + (size_t)u.pn * bt; }
};

template <int ACT> struct EpiBf16 {
    static constexpr bool PERM = true;
    bf16_t* O; int ldc;
    __device__ __forceinline__ void operator()(const f32x4 (&acc)[2][2][4][2], const Unit& u, int wr, int wc, int fr, int fq) const {
        const int row0 = u.pm * BM + wr * 64 + fr, col0 = u.pn * BM + wc * 32 + 8 * fq;
#pragma unroll
        for (int ai = 0; ai < 2; ++ai)
#pragma unroll
            for (int m = 0; m < 4; ++m) { bf16_t* rowp = O + (size_t)(row0 + ai * HALF + m * 16) * ldc + col0;
#pragma unroll
                for (int bj = 0; bj < 2; ++bj) { f32x4 v0 = acc[ai][bj][m][0], v1 = acc[ai][bj][m][1];
                    if (ACT == 1) {
#pragma unroll
                        for (int j = 0; j < 4; ++j) { v0[j] = sigm(v0[j]); v1[j] = sigm(v1[j]); } }
                    u32x4 w; w.x = pk2(v0[0], v0[1]); w.y = pk2(v0[2], v0[3]); w.z = pk2(v1[0], v1[1]); w.w = pk2(v1[2], v1[3]);
                    *(u32x4*)(rowp + bj * HALF) = w; } }
    }
};
struct EpiBranch {
    static constexpr bool PERM = true;
    bf16_t* MB; const bf16_t* G;
    __device__ __forceinline__ void operator()(const f32x4 (&acc)[2][2][4][2], const Unit& u, int wr, int wc, int fr, int fq) const {
        const int row0 = u.pm * BM + wr * 64 + fr, col0 = u.pn * BM + wc * 32 + 8 * fq;
#pragma unroll
        for (int ai = 0; ai < 2; ++ai)
#pragma unroll
          for (int mp = 0; mp < 2; ++mp) {
            u32x4 g[2][2], pv[2][2];
#pragma unroll
            for (int mm = 0; mm < 2; ++mm)
#pragma unroll
                for (int bj = 0; bj < 2; ++bj) { const size_t r = (size_t)(row0 + ai * HALF + (2 * mp + mm) * 16);
                    g[mm][bj] = *(const u32x4*)(G + r * NGATE + u.z * D + col0 + bj * HALF);
                    pv[mm][bj] = (u32x4){0u, 0u, 0u, 0u}; if (u.z) pv[mm][bj] = *(const u32x4*)(MB + r * D + col0 + bj * HALF); }
#pragma unroll
            for (int mm = 0; mm < 2; ++mm)
#pragma unroll
                for (int bj = 0; bj < 2; ++bj) { const int m = 2 * mp + mm; const size_t r = (size_t)(row0 + ai * HALF + m * 16);
                    const f32x4 v0 = acc[ai][bj][m][0], v1 = acc[ai][bj][m][1];
                    float o[8];
                    o[0] = v0[0]; o[1] = v0[1]; o[2] = v0[2]; o[3] = v0[3]; o[4] = v1[0]; o[5] = v1[1]; o[6] = v1[2]; o[7] = v1[3];
                    u32x4 w;
#pragma unroll
                    for (int q = 0; q < 4; ++q) {
                        const float g0 = sigm(__uint_as_float(g[mm][bj][q] << 16)), g1 = sigm(__uint_as_float(g[mm][bj][q] & 0xffff0000u));
                        const float p0 = __uint_as_float(pv[mm][bj][q] << 16), p1 = __uint_as_float(pv[mm][bj][q] & 0xffff0000u);
                        w[q] = pk2(p0 + g0 * o[2 * q], p1 + g1 * o[2 * q + 1]); }
                    *(u32x4*)(MB + r * D + col0 + bj * HALF) = w; } }
    }
};
struct EpiResid {
    static constexpr bool PERM = false;
    float* H; const float* S;
    __device__ __forceinline__ void operator()(const f32x4 (&acc)[2][2][4][2], const Unit& u, int wr, int wc, int fr, int fq) const {
        const int row0 = u.pm * BM + wr * 64 + fr, col0 = u.pn * BM + wc * 32 + 4 * fq;
#pragma unroll
        for (int ai = 0; ai < 2; ++ai)
#pragma unroll
            for (int mp = 0; mp < 2; ++mp) {
                f32x4 old[2][2][2];
#pragma unroll
                for (int mm = 0; mm < 2; ++mm)
#pragma unroll
                    for (int bj = 0; bj < 2; ++bj)
#pragma unroll
                        for (int n = 0; n < 2; ++n) old[mm][bj][n] = *(const f32x4*)(S + (size_t)(row0 + ai * HALF + (2 * mp + mm) * 16) * D + col0 + bj * HALF + n * 16);
#pragma unroll
                for (int mm = 0; mm < 2; ++mm)
#pragma unroll
                    for (int bj = 0; bj < 2; ++bj)
#pragma unroll
                        for (int n = 0; n < 2; ++n) *(f32x4*)(H + (size_t)(row0 + ai * HALF + (2 * mp + mm) * 16) * D + col0 + bj * HALF + n * 16) = old[mm][bj][n] + acc[ai][bj][2 * mp + mm][n]; }
    }
};
struct EpiSwiglu {
    static constexpr bool PERM = true;
    bf16_t* FF;
    __device__ __forceinline__ void operator()(const f32x4 (&acc)[2][2][4][2], const Unit& u, int wr, int wc, int fr, int fq) const {
        const int row0 = u.pm * BM + wr * 64 + fr, col0 = u.pn * HALF + wc * 32 + 8 * fq;
#pragma unroll
        for (int ai = 0; ai < 2; ++ai)
#pragma unroll
            for (int m = 0; m < 4; ++m) { bf16_t* rowp = FF + (size_t)(row0 + ai * HALF + m * 16) * DFF + col0;
                const f32x4 g0 = acc[ai][0][m][0], g1 = acc[ai][0][m][1], u0 = acc[ai][1][m][0], u1 = acc[ai][1][m][1];
                u32x4 w; w.x = pk2(siluf(g0[0]) * u0[0], siluf(g0[1]) * u0[1]); w.y = pk2(siluf(g0[2]) * u0[2], siluf(g0[3]) * u0[3]);
                w.z = pk2(siluf(g1[0]) * u1[0], siluf(g1[1]) * u1[1]); w.w = pk2(siluf(g1[2]) * u1[2], siluf(g1[3]) * u1[3]);
                *(u32x4*)rowp = w; }
    }
};

template <class Epi, class Sched>
__device__ __forceinline__ void gemm_phase(LAS unsigned char* lds, const int lda, const int ldb, const int K, const Sched& S, const Epi& E) {
    const int tid = opaque_tid(), wid = __builtin_amdgcn_readfirstlane(tid >> 6), lane = tid & 63, wr = wid >> 2, wc = wid & 3, fr = lane & 15, fq = lane >> 4;
    const int nt = K / BK;
    unsigned voffA[2], voffB[2];
#pragma unroll
    for (int i = 0; i < 2; ++i) { int R, C; stage_rc(tid * 16 + i * 8192, R, C); const int Rb = Epi::PERM ? ((R & ~31) + perm32(R & 31)) : R;
        voffA[i] = (unsigned)(R * lda + C) * 2u; voffB[i] = (unsigned)(Rb * ldb + C) * 2u; }
    const size_t kstep = (size_t)(BK * 2);
    const size_t hstepA = (size_t)HALF * lda * 2, hstepB = (size_t)HALF * ldb * 2;
    const unsigned ldsw = (unsigned)wid * 1024u;
    const int aoff = lds_byte(wr * 64 + fr, fq * 8), boff = lds_byte(wc * 32 + fr, fq * 8);
#define PG8_SA(b, h) (((b) * 2 + (h)) * HTB)
#define PG8_SB(b, h) ((4 + (b) * 2 + (h)) * HTB)
#define PG8_STAGE(bufoff, gbase, voff) do { _Pragma("unroll") for (int _i = 0; _i < 2; ++_i) \
        __builtin_amdgcn_global_load_lds((const unsigned*)((const char*)(gbase) + (voff)[_i]), (LAS unsigned*)(lds + (bufoff) + ldsw + _i * 8192), 16, 0, 0); } while (0)
#define PG8_LDA(dst, b, h) do { _Pragma("unroll") for (int m = 0; m < 4; ++m) _Pragma("unroll") for (int k = 0; k < 2; ++k) dst[m][k] = *(const LAS bf16x8*)(lds + PG8_SA(b, h) + aoff + m * 2048 + k * 1024); } while (0)
#define PG8_LDB(dst, b, h) do { _Pragma("unroll") for (int n = 0; n < 2; ++n) _Pragma("unroll") for (int k = 0; k < 2; ++k) dst[n][k] = *(const LAS bf16x8*)(lds + PG8_SB(b, h) + boff + n * 2048 + k * 1024); } while (0)
#define PG8_MMA(ai, bj, At, Bt) do { __builtin_amdgcn_s_setprio(1); _Pragma("unroll") for (int m = 0; m < 4; ++m) _Pragma("unroll") for (int n = 0; n < 2; ++n) _Pragma("unroll") for (int k = 0; k < 2; ++k) \
        acc[ai][bj][m][n] = __builtin_amdgcn_mfma_f32_16x16x32_bf16(Bt[n][k], At[m][k], acc[ai][bj][m][n], 0, 0, 0); __builtin_amdgcn_s_setprio(0); } while (0)
#define PG8_WAIT_V(n) asm volatile("s_waitcnt vmcnt(" #n ")" ::: "memory")
#define PG8_WAIT_L(n) asm volatile("s_waitcnt lgkmcnt(" #n ")" ::: "memory")
#define PG8_BAR __builtin_amdgcn_s_barrier()
#define PG8_SCHED __builtin_amdgcn_sched_barrier(0)
    Unit cur, nxt; int ui = 0;
    if (!S.next(0, cur)) return;
    f32x4 acc[2][2][4][2];
#pragma unroll
    for (int a = 0; a < 2; ++a)
#pragma unroll
        for (int b = 0; b < 2; ++b)
#pragma unroll
            for (int m = 0; m < 4; ++m)
#pragma unroll
                for (int n = 0; n < 2; ++n) acc[a][b][m][n] = (f32x4){0.f, 0.f, 0.f, 0.f};
    bf16x8 At[4][2], B0[2][2], B1[2][2];
    const char* cA = S.aptr(cur); const char* cB = S.bptr(cur);
    PG8_STAGE(PG8_SB(0, 0), cB, voffB); PG8_STAGE(PG8_SA(0, 0), cA, voffA); PG8_STAGE(PG8_SB(0, 1), cB + hstepB, voffB); PG8_STAGE(PG8_SA(0, 1), cA + hstepA, voffA);
    if (wr == 1) PG8_BAR;
    PG8_WAIT_V(4); PG8_BAR;
    PG8_STAGE(PG8_SB(1, 0), cB + kstep, voffB); PG8_STAGE(PG8_SA(1, 0), cA + kstep, voffA); PG8_STAGE(PG8_SB(1, 1), cB + hstepB + kstep, voffB);
    PG8_WAIT_V(6); PG8_BAR;
    for (;;) {
        const bool has_next = S.next(ui + 1, nxt);
        const char* nA = has_next ? S.aptr(nxt) : cA; const char* nB = has_next ? S.bptr(nxt) : cB;
        for (int t = 0; t < nt; t += 2) {
            const bool last = (t == nt - 2);
            const char* a1 = cA + (size_t)(t + 1) * kstep;
            const char* a2 = last ? nA : cA + (size_t)(t + 2) * kstep; const char* b2 = last ? nB : cB + (size_t)(t + 2) * kstep;
            const char* a3 = a2 + kstep; const char* b3 = b2 + kstep;
            PG8_LDB(B0, 0, 0); PG8_SCHED; PG8_LDA(At, 0, 0); PG8_STAGE(PG8_SA(1, 1), a1 + hstepA, voffA);
            PG8_WAIT_L(8); PG8_BAR; PG8_WAIT_L(0); PG8_MMA(0, 0, At, B0); PG8_BAR; PG8_SCHED;
            PG8_LDB(B1, 0, 1); PG8_STAGE(PG8_SB(0, 0), b2, voffB);
            PG8_BAR; PG8_WAIT_L(0); PG8_MMA(0, 1, At, B1); PG8_BAR;
            PG8_LDA(At, 0, 1); PG8_STAGE(PG8_SA(0, 0), a2, voffA);
            PG8_BAR; PG8_WAIT_L(0); PG8_MMA(1, 0, At, B0); PG8_BAR; PG8_SCHED;
            PG8_STAGE(PG8_SB(0, 1), b2 + hstepB, voffB);
            PG8_WAIT_V(6); PG8_BAR; PG8_MMA(1, 1, At, B1); PG8_BAR;
            PG8_LDB(B0, 1, 0); PG8_SCHED; PG8_LDA(At, 1, 0); PG8_STAGE(PG8_SA(0, 1), a2 + hstepA, voffA);
            PG8_WAIT_L(8); PG8_BAR; PG8_WAIT_L(0); PG8_MMA(0, 0, At, B0); PG8_BAR; PG8_SCHED;
            PG8_LDB(B1, 1, 1); PG8_STAGE(PG8_SB(1, 0), b3, voffB);
            PG8_BAR; PG8_WAIT_L(0); PG8_MMA(0, 1, At, B1); PG8_BAR;
            PG8_LDA(At, 1, 1); PG8_STAGE(PG8_SA(1, 0), a3, voffA);
            PG8_BAR; PG8_WAIT_L(0); PG8_MMA(1, 0, At, B0); PG8_BAR; PG8_SCHED;
            PG8_STAGE(PG8_SB(1, 1), b3 + hstepB, voffB);
            PG8_WAIT_V(6); PG8_BAR; PG8_MMA(1, 1, At, B1); PG8_BAR;
        }
        E(acc, cur, wr, wc, fr, fq);
        if (!has_next) break;
#pragma unroll
        for (int a = 0; a < 2; ++a)
#pragma unroll
            for (int b = 0; b < 2; ++b)
#pragma unroll
                for (int m = 0; m < 4; ++m)
#pragma unroll
                    for (int n = 0; n < 2; ++n) acc[a][b][m][n] = (f32x4){0.f, 0.f, 0.f, 0.f};
        cur = nxt; cA = nA; cB = nB; ++ui;
    }
    PG8_WAIT_V(0);
    if (wr == 0) PG8_BAR;
    PG8_BAR;
#undef PG8_SA
#undef PG8_SB
#undef PG8_STAGE
#undef PG8_LDA
#undef PG8_LDB
#undef PG8_MMA
#undef PG8_WAIT_V
#undef PG8_WAIT_L
#undef PG8_BAR
#undef PG8_SCHED
}
}

struct XpItem { const float* src; bf16_t* dst; int K, N, k0, n0, row0; };
__device__ __forceinline__ void xpose_load(const XpItem& x, int lane, f32x4 (&v)[8]) {
#pragma unroll
    for (int i = 0; i < 8; ++i) v[i] = *(const f32x4*)(x.src + (size_t)(x.k0 + 8 * i + (lane >> 3)) * x.N + x.n0 + (lane & 7) * 4);
}
__device__ __forceinline__ void xpose_finish(const XpItem& x, int lane, const f32x4 (&v)[8], LAS float* scr) {
#pragma unroll
    for (int i = 0; i < 8; ++i) { LAS float* d = scr + (8 * i + (lane >> 3)) * 33 + (lane & 7) * 4; d[0] = v[i][0]; d[1] = v[i][1]; d[2] = v[i][2]; d[3] = v[i][3]; }
    LDS_WAIT(); asm volatile("" ::: "memory");
    const int c = lane & 7;
#pragma unroll
    for (int j = 0; j < 4; ++j) { const int n = (lane >> 3) + 8 * j; const LAS float* s = scr + (8 * c) * 33 + n;
        u32x4 o; o.x = pk2(s[0 * 33], s[1 * 33]); o.y = pk2(s[2 * 33], s[3 * 33]); o.z = pk2(s[4 * 33], s[5 * 33]); o.w = pk2(s[6 * 33], s[7 * 33]);
        *(u32x4*)(x.dst + (size_t)(x.row0 + n) * x.K + x.k0 + 8 * c) = o; }
    LDS_WAIT(); asm volatile("" ::: "memory");
}

__device__ __forceinline__ float wave_sum(float v) {
#pragma unroll
    for (int o = 1; o < 64; o <<= 1) v += __shfl_xor(v, o);
    return v;
}

__device__ __forceinline__ void norm_rows(CParams& p, int mode, const float* gain, int nrows) {
    float* H = (float*)(p.ws + OFF_H); bf16_t* NB = (bf16_t*)(p.ws + OFF_NB);
    const int tid0 = opaque_tid(); const int lane = tid0 & 63, gw = blockIdx.x * 8 + (tid0 >> 6), NW = gridDim.x * 8;
    for (int row = gw; row < nrows; row += NW) {
        f32x4 v[8];
        if (mode == 0) {
            const float* src = nullptr;
            if (row < MX) src = p.in[0] + (size_t)row * D;
            else { const int i = (row - MX) & 127; if (i >= 112) src = p.in[1] + (size_t)(i - 112) * D; }
#pragma unroll
            for (int j = 0; j < 8; ++j) { v[j] = src ? *(const f32x4*)(src + (lane + 64 * j) * 4) : (f32x4){0.f, 0.f, 0.f, 0.f}; if (row >= MX) *(f32x4*)(H + (size_t)row * D + (lane + 64 * j) * 4) = v[j]; }
        } else {
#pragma unroll
            for (int j = 0; j < 8; ++j) v[j] = *(const f32x4*)(H + (size_t)row * D + (lane + 64 * j) * 4);
        }
        float s = 0.f;
#pragma unroll
        for (int j = 0; j < 8; ++j) s += (v[j][0] * v[j][0] + v[j][1] * v[j][1]) + (v[j][2] * v[j][2] + v[j][3] * v[j][3]);
        const float rs = 1.0f / sqrtf(wave_sum(s) * (1.0f / D) + EPS);
#pragma unroll
        for (int j = 0; j < 8; ++j) {
            const f32x4 g = *(const f32x4*)(gain + (lane + 64 * j) * 4);
            const f32x4 y = v[j] * rs * g;
            if (mode == 3) *(f32x4*)(p.out + (size_t)row * D + (lane + 64 * j) * 4) = y;
            else { u32x2 w; w.x = pk2(y[0], y[1]); w.y = pk2(y[2], y[3]); *(u32x2*)(NB + (size_t)row * D + (lane + 64 * j) * 4) = w; }
        }
    }
}

constexpr int FPOS = 36;
__device__ __forceinline__ void filter_item(CParams& p, int layer, int it, LAS float* l) {
    LAS float* Zf = l; LAS float* H1 = l + FPOS * 33; LAS float* H2T = H1 + FPOS * 64;
    LAS float* W1L = H2T + 64 * FPOS; LAS float* W2L = W1L + 33 * 64;
    const int tid = opaque_tid(), n0 = it * FPOS;
    const float* w1 = p.in[14] + layer * 33 * 64; const float* b1 = p.in[15] + layer * 64; const float* w2 = p.in[16] + layer * 64 * 64;
    const float* b2 = p.in[17] + layer * 64; const float* w3 = p.in[18] + layer * 64 * 1024; const float* decay = p.in[19] + layer * 1024;
    bf16_t* GR = (bf16_t*)(p.ws + R_GR);
    __syncthreads();
    {
        const f32x4 t0 = *(const f32x4*)(w1 + 4 * tid), t2 = *(const f32x4*)(w2 + 4 * tid), t3 = *(const f32x4*)(w2 + 2048 + 4 * tid);
        f32x4 t1 = (f32x4){0.f, 0.f, 0.f, 0.f}; if (tid < 16) t1 = *(const f32x4*)(w1 + 2048 + 4 * tid);
        *(LAS f32x4*)(W1L + 4 * tid) = t0; if (tid < 16) *(LAS f32x4*)(W1L + 2048 + 4 * tid) = t1;
        *(LAS f32x4*)(W2L + 4 * tid) = t2; *(LAS f32x4*)(W2L + 2048 + 4 * tid) = t3; }
    for (int idx = tid; idx < FPOS * 33; idx += 512) { const int pos = idx / 33, e = idx % 33, n = n0 + pos; float v;
        if (e == 0) v = (float)n / 8207.0f;
        else { const int k = (e - 1) & 15; const float fr = 1e-4f + (float)k * ((15.0f - 1e-4f) / 15.0f); const double rev = (double)n * (double)fr * (1.0 / 8208.0); const float fx = (float)(rev - floor(rev));
               v = (e <= 16) ? __builtin_amdgcn_cosf(fx) : -__builtin_amdgcn_sinf(fx); }
        Zf[pos * 33 + e] = v; }
    __syncthreads();
    for (int pos = tid >> 4; pos < FPOS; pos += 32) { const int k4 = (tid & 15) * 4; float a[4];
#pragma unroll
      for (int q = 0; q < 4; ++q) a[q] = b1[k4 + q];
#pragma unroll 3
      for (int e = 0; e < 33; ++e) { const float z = Zf[pos * 33 + e];
#pragma unroll
          for (int q = 0; q < 4; ++q) a[q] += z * W1L[e * 64 + k4 + q]; }
#pragma unroll
      for (int q = 0; q < 4; ++q) H1[pos * 64 + k4 + q] = __builtin_amdgcn_sinf(a[q] * 0.15915494309189535f); }
    __syncthreads();
    for (int pos = tid >> 4; pos < FPOS; pos += 32) { const int k4 = (tid & 15) * 4; float a[4];
#pragma unroll
      for (int q = 0; q < 4; ++q) a[q] = b2[k4 + q];
#pragma unroll 4
      for (int j = 0; j < 64; ++j) { const float z = H1[pos * 64 + j];
#pragma unroll
          for (int q = 0; q < 4; ++q) a[q] += z * W2L[j * 64 + k4 + q]; }
#pragma unroll
      for (int q = 0; q < 4; ++q) H2T[(k4 + q) * FPOS + pos] = __builtin_amdgcn_sinf(a[q] * 0.15915494309189535f); }
    __syncthreads();
    { float acc0[FPOS], acc1[FPOS];
#pragma unroll
      for (int q = 0; q < FPOS; ++q) { acc0[q] = 0.f; acc1[q] = 0.f; }
#pragma unroll 1
      for (int k8 = 0; k8 < 64; k8 += 8) { float wa8[8], wb8[8];
#pragma unroll
        for (int kk = 0; kk < 8; ++kk) { wa8[kk] = w3[(k8 + kk) * 1024 + tid]; wb8[kk] = w3[(k8 + kk) * 1024 + 512 + tid]; }
#pragma unroll
        for (int kk = 0; kk < 8; ++kk) { const int k = k8 + kk; const float wa = wa8[kk], wb = wb8[kk];
#pragma unroll
          for (int p4 = 0; p4 < FPOS / 4; ++p4) { const f32x4 h = *(const LAS f32x4*)(H2T + k * FPOS + p4 * 4);
#pragma unroll
              for (int q = 0; q < 4; ++q) { acc0[4 * p4 + q] += h[q] * wa; acc1[4 * p4 + q] += h[q] * wb; } } } }
      const float da = fabsf(decay[tid]), db = fabsf(decay[512 + tid]);
      static_assert(T % FPOS == 0 && FPOS % 4 == 0 && (GROFF % 4) == 0, "filter store grouping");
      bf16_t* gf = GR + (size_t)tid * GRN + (GROFF - n0);
      bf16_t* gb = GR + (size_t)tid * GRN + (GROFF + n0);
      const float sa = -da / 8207.0f, sb = -db / 8207.0f;
#define FE0(q) (acc0[q] * __expf(sa * (float)(n0 + (q))))
#define FE1(q) (acc1[q] * __expf(sb * (float)(n0 + (q))))
      gf[0] = (bf16_t)f2bf(FE0(0));
#pragma unroll
      for (int k = 1; k <= 8; ++k) { u32x2 w; w.x = pk2(FE0(4 * k), FE0(4 * k - 1)); w.y = pk2(FE0(4 * k - 2), FE0(4 * k - 3)); *(u32x2*)(gf - 4 * k) = w; }
      *(unsigned*)(gf - 34) = pk2(FE0(34), FE0(33));
      gf[-35] = (bf16_t)f2bf(FE0(35));
      if (it == 0) { gb[1] = (bf16_t)f2bf(FE1(1)); gb[2] = (bf16_t)f2bf(FE1(2)); gb[3] = (bf16_t)f2bf(FE1(3)); }
      else { u32x2 w; w.x = pk2(FE1(0), FE1(1)); w.y = pk2(FE1(2), FE1(3)); *(u32x2*)gb = w; }
#pragma unroll
      for (int k = 1; k < 9; ++k) { u32x2 w; w.x = pk2(FE1(4 * k), FE1(4 * k + 1)); w.y = pk2(FE1(4 * k + 2), FE1(4 * k + 3)); *(u32x2*)(gb + 4 * k) = w; }
#undef FE0
#undef FE1
    }
}

__device__ __forceinline__ void phase_prep(CParams& p, int layer, LAS unsigned char* lds) {
    const int tid = opaque_tid(), lane = tid & 63, wave = tid >> 6;
    for (int it = blockIdx.x; it < (T + FPOS - 1) / FPOS; it += gridDim.x) filter_item(p, layer, it, (LAS float*)lds);
    __syncthreads();
    if (layer == 0) {
        f32x2* RT = (f32x2*)(p.ws + OFF_ROPE);
        for (int idx = blockIdx.x * 512 + tid; idx < T * 64; idx += gridDim.x * 512) { const int pos = idx >> 6, j = idx & 63;
            double inv = 1.0; for (int q = 0; q < j; ++q) inv *= 0.8659643233600653; const double rev = (double)pos * inv * 0.15915494309189535; const float fx = (float)(rev - floor(rev));
            RT[idx] = (f32x2){__builtin_amdgcn_cosf(fx), __builtin_amdgcn_sinf(fx)}; }
    }
    if (blockIdx.x == 0) { const float l0 = p.in[21][tid], l1 = p.in[21][W + tid]; ((float*)(p.ws + OFF_LBT))[tid] = (layer == 1) ? 1.0f / (1.0f + expf(l0 - l1)) : 0.f; }
    { bf16_t* Wg = (bf16_t*)(p.ws + OFF_LRUW);
      for (int idx = blockIdx.x * 512 + tid; idx < 131072; idx += gridDim.x * 512) { const int i = idx & 63, jj = (idx >> 6) & 63, kb = (idx >> 12) & 7, m = idx >> 15;
          const float* src = (m & 1) ? p.in[9] : p.in[7]; Wg[idx] = (bf16_t)f2bf(src[(size_t)((layer * 2 + (m >> 1)) * 8 + kb) * 4096 + i * 64 + jj]); } }
    LAS float* scr = (LAS float*)lds + wave * (64 * 33);
    const int gw = blockIdx.x * 8 + wave, NW = gridDim.x * 8;
    constexpr int I_IN = 32 * 480, I_BO = 8 * 64, I_OUT = 32 * 64, I_G = 32 * 176, I_D = 88 * 64;
    constexpr int NIT = I_IN + 4 * I_BO + I_OUT + 2 * I_G + I_D;
    auto decode = [&](int it, XpItem& x) {
        int r = it;
        if (r < I_IN) { const int nb = r % 480, kb = r / 480; x = XpItem{p.in[4] + (size_t)layer * D * 15360, (bf16_t*)(p.ws + OFF_WIN), D, 15360, kb * 64, nb * 32, nb * 32}; return; } r -= I_IN;
        if (r < 4 * I_BO) { const int z = r / I_BO, q = r % I_BO, nb = q % 64, kb = q / 64;
            x = XpItem{p.in[22] + ((size_t)layer * 4 + z) * W * D, (bf16_t*)(p.ws + OFF_WBO) + (size_t)z * D * W, W, D, kb * 64, nb * 32, nb * 32}; return; } r -= 4 * I_BO;
        if (r < I_OUT) { const int nb = r % 64, kb = r / 64; x = XpItem{p.in[23] + (size_t)layer * D * D, (bf16_t*)(p.ws + OFF_WOUT), D, D, kb * 64, nb * 32, nb * 32}; return; } r -= I_OUT;
        if (r < 2 * I_G) { const int up = r / I_G, q = r % I_G, nb = q % 176, kb = q / 176, n0 = nb * 32;
            x = XpItem{p.in[up ? 25 : 24] + (size_t)layer * D * DFF, (bf16_t*)(p.ws + OFF_WGU), D, DFF, kb * 64, n0, 256 * (n0 >> 7) + (n0 & 127) + up * 128}; return; } r -= 2 * I_G;
        { const int nb = r % 64, kb = r / 64; x = XpItem{p.in[26] + (size_t)layer * DFF * D, (bf16_t*)(p.ws + OFF_WD), DFF, D, kb * 64, nb * 32, nb * 32}; }
    };
    {
        XpItem cur, nxt; f32x4 vc[8], vn[8];
        int it = gw;
        if (it < NIT) { decode(it, cur); xpose_load(cur, lane, vc); }
        for (; it < NIT; it += NW) {
            const bool hn = (it + NW) < NIT;
            if (hn) { decode(it + NW, nxt); xpose_load(nxt, lane, vn); }
            xpose_finish(cur, lane, vc, scr);
            if (hn) { cur = nxt;
#pragma unroll
                for (int i = 0; i < 8; ++i) vc[i] = vn[i]; }
        }
    }
    norm_rows(p, layer == 0 ? 0 : 1, p.in[2] + layer * D, MP);
}

__device__ __forceinline__ void lru_s1_item(CParams& p, int layer, int item, LAS unsigned char* lds) {
    const int cidx = item >> 3, kb = item & 7, b = cidx / NCHK, c = cidx % NCHK;
    const int tid = opaque_tid(), lane = tid & 63, wave = tid >> 6;
    constexpr int XS = 72;
    LAS bf16_t* XCb = (LAS bf16_t*)lds;
    LAS bf16_t* WT = XCb + 128 * XS;
    LAS float* XCf = (LAS float*)(lds + (128 + 256) * XS * 2);
    LAS float* AG = XCf + 8192;
    const bf16_t* P = (const bf16_t*)(p.ws + R_PMIX);
    bf16_t* LA = (bf16_t*)(p.ws + R_LA); bf16_t* BB = (bf16_t*)(p.ws + R_BB);
    __syncthreads();
    {
        const bf16_t* Wg = (const bf16_t*)(p.ws + OFF_LRUW);
        for (int q = tid; q < 2048; q += 512) { const int n = q >> 3, part = q & 7, m = n >> 6, jj = n & 63;
            *(LAS u32x4*)(WT + n * XS + part * 8) = *(const u32x4*)(Wg + ((size_t)(m * 8 + kb) * 64 + jj) * 64 + part * 8); } }
    {
        const int j = tid & 63, tq = tid >> 6, ch = kb * 64 + j;
        const float* cw = p.in[5] + layer * 4 * W; const float cb = p.in[6][layer * W + ch];
        const float w0 = cw[ch], w1 = cw[W + ch], w2 = cw[2 * W + ch], w3 = cw[3 * W + ch];
        const int t0 = c * 128 + 16 * tq - 112;
        float xv[19];
#pragma unroll
        for (int q = 0; q < 19; ++q) { const int t = t0 - 2 + q; xv[q] = (t >= 0 && t < T) ? bf2f(P[(size_t)row_of(b, t) * NMIX + ch]) : 0.f; }
#pragma unroll
        for (int tt = 0; tt < 16; ++tt) { const float x = cb + w0 * xv[tt] + w1 * xv[tt + 1] + w2 * xv[tt + 2] + w3 * xv[tt + 3];
            XCf[(16 * tq + tt) * 64 + j] = x; XCb[(16 * tq + tt) * XS + j] = (bf16_t)f2bf(x); } }
    __syncthreads();
    const int r = lane & 15, h = lane >> 4;
    f32x4 acc[16];
#pragma unroll
    for (int nt = 0; nt < 16; ++nt) acc[nt] = (f32x4){0.f, 0.f, 0.f, 0.f};
#pragma unroll
    for (int ks = 0; ks < 2; ++ks) { const bf16x8 a = *(const LAS bf16x8*)(XCb + (16 * wave + r) * XS + 32 * ks + 8 * h);
#pragma unroll
        for (int nt = 0; nt < 16; ++nt) { const bf16x8 bw = *(const LAS bf16x8*)(WT + (16 * nt + r) * XS + 32 * ks + 8 * h);
            acc[nt] = __builtin_amdgcn_mfma_f32_16x16x32_bf16(a, bw, acc[nt], 0, 0, 0); } }
    const int tok0 = 16 * wave + 4 * h, t0 = c * 128 + tok0 - 112;
#pragma unroll
    for (int jt = 0; jt < 4; ++jt) { const int j = 16 * jt + r, ch = kb * 64 + j;
#pragma unroll
        for (int dir = 0; dir < 2; ++dir) {
            const float ba = p.in[8][(layer * 2 + dir) * W + ch], bx = p.in[10][(layer * 2 + dir) * W + ch], lam = p.in[11][(layer * 2 + dir) * W + ch];
            const float sp = log1pf(expf(-lam));
            float Aq = 1.f, Bq = 0.f;
#pragma unroll
            for (int s = 0; s < 4; ++s) { const int q = dir ? 3 - s : s;
                const float rg = sigm(acc[(2 * dir) * 4 + jt][q] + ba), ig = sigm(acc[(2 * dir + 1) * 4 + jt][q] + bx);
                float la = -8.0f * rg * sp; float bv = sqrtf(fmaxf(1.0f - __expf(2.0f * la), 0.f)) * ig * XCf[(tok0 + q) * 64 + j];
                if ((t0 + q) < 0) { la = 0.f; bv = 0.f; }
                const unsigned lab = f2bf(la), bvb = f2bf(bv);
                const size_t ro = (size_t)row_bci(b, c, tok0 + q) * W + ch;
                LA[(size_t)dir * MP * W + ro] = (bf16_t)lab; BB[(size_t)dir * MP * W + ro] = (bf16_t)bvb;
                const float a = __expf(__uint_as_float(lab << 16)), bq = __uint_as_float(bvb << 16);
                Bq = a * Bq + bq; Aq *= a; }
            const int g = 4 * wave + h;
            AG[((g * 2 + dir) * 2 + 0) * 64 + j] = Aq; AG[((g * 2 + dir) * 2 + 1) * 64 + j] = Bq; } }
    __syncthreads();
    if (tid < 128) { const int dir = tid >> 6, jj = tid & 63; float At = 1.f, Bt = 0.f;
        for (int s = 0; s < 32; ++s) { const int q = dir ? 31 - s : s; const float a = AG[((q * 2 + dir) * 2 + 0) * 64 + jj], bq = AG[((q * 2 + dir) * 2 + 1) * 64 + jj]; Bt = a * Bt + bq; At *= a; }
        const size_t o = (size_t)((dir * 2 + b) * NCHK + c) * W + kb * 64 + jj;
        ((float*)(p.ws + R_CA))[o] = At; ((float*)(p.ws + R_CB))[o] = Bt; }
}

__device__ __forceinline__ void lru_carry(CParams& p) {
    const int gt = blockIdx.x * 512 + opaque_tid();
    if (gt < 2048) { const int dir = gt >> 10, b = (gt >> 9) & 1, ch = gt & 511;
        const float* CA = (const float*)(p.ws + R_CA); const float* CB = (const float*)(p.ws + R_CB); float* CR = (float*)(p.ws + R_CR);
        const size_t base = (size_t)((dir * 2 + b) * NCHK) * W + ch; float h = 0.f;
        for (int s0 = 0; s0 < NCHK; s0 += 5) { float a[5], bq[5];
#pragma unroll
            for (int q = 0; q < 5; ++q) { const int c = dir ? NCHK - 1 - (s0 + q) : (s0 + q); a[q] = CA[base + (size_t)c * W]; bq[q] = CB[base + (size_t)c * W]; }
#pragma unroll
            for (int q = 0; q < 5; ++q) { const int c = dir ? NCHK - 1 - (s0 + q) : (s0 + q); CR[base + (size_t)c * W] = h; h = a[q] * h + bq[q]; } } }
}

__device__ __forceinline__ void lru_s3_item(CParams& p, int item, LAS unsigned char* lds) {
    const int cidx = item >> 3, kb = item & 7, b = cidx / NCHK, c = cidx % NCHK;
    const int tid = opaque_tid(), j = tid & 63, tq = tid >> 6, ch = kb * 64 + j;
    LAS float* AG = (LAS float*)lds;
    const bf16_t* P = (const bf16_t*)(p.ws + R_PMIX); const bf16_t* LA = (const bf16_t*)(p.ws + R_LA); const bf16_t* BB = (const bf16_t*)(p.ws + R_BB);
    bf16_t* Z = (bf16_t*)(p.ws + OFF_Z);
    float av[2][16], bv[2][16];
    size_t ro[16];
#pragma unroll
    for (int tt = 0; tt < 16; ++tt) ro[tt] = (size_t)row_bci(b, c, 16 * tq + tt);
#pragma unroll
    for (int dir = 0; dir < 2; ++dir)
#pragma unroll
        for (int tt = 0; tt < 16; ++tt) { const size_t o = (size_t)dir * MP * W + ro[tt] * W + ch; av[dir][tt] = bf2f(LA[o]); bv[dir][tt] = bf2f(BB[o]); }
    __syncthreads();
#pragma unroll
    for (int dir = 0; dir < 2; ++dir) { float Aq = 1.f, Bq = 0.f;
#pragma unroll
        for (int s = 0; s < 16; ++s) { const int tt = dir ? 15 - s : s; const float a = __expf(av[dir][tt]); av[dir][tt] = a; Bq = a * Bq + bv[dir][tt]; Aq *= a; }
        AG[((tq * 2 + dir) * 2 + 0) * 64 + j] = Aq; AG[((tq * 2 + dir) * 2 + 1) * 64 + j] = Bq; }
    __syncthreads();
    float hs[16];
#pragma unroll
    for (int dir = 0; dir < 2; ++dir) {
        float h = ((const float*)(p.ws + R_CR))[(size_t)((dir * 2 + b) * NCHK + c) * W + ch];
        for (int s = 0; s < 7; ++s) { const int q = dir ? 7 - s : s; const bool use = dir ? (q > tq) : (q < tq);
            const float a = AG[((q * 2 + dir) * 2 + 0) * 64 + j], bq = AG[((q * 2 + dir) * 2 + 1) * 64 + j]; if (use) h = a * h + bq; }
#pragma unroll
        for (int s = 0; s < 16; ++s) { const int tt = dir ? 15 - s : s; h = av[dir][tt] * h + bv[dir][tt]; if (dir == 0) hs[tt] = h; else hs[tt] += h; }
    }
#pragma unroll
    for (int tt = 0; tt < 16; ++tt) { const int i = 16 * tq + tt; const bool valid = (c * 128 + i - 112) >= 0;
        const float ga = bf2f(P[ro[tt] * NMIX + 512 + ch]);
        Z[ro[tt] * D + ch] = (bf16_t)(valid ? f2bf(hs[tt] * gelu_tanh(ga)) : 0u); }
}

__device__ __forceinline__ void conv3_16(const bf16_t* P, const float* cw, const float* cbias, int b, int t0, int col, float (&out)[16]) {
    const int cc = col - 1024; const float w0 = cw[cc], w1 = cw[1536 + cc], w2 = cw[3072 + cc], bb = cbias[cc];
    float xv[18];
#pragma unroll
    for (int q = 0; q < 18; ++q) { const int t = t0 - 1 + q; xv[q] = (t >= 0 && t < T) ? bf2f(P[(size_t)row_of(b, t) * NMIX + col]) : 0.f; }
#pragma unroll
    for (int tt = 0; tt < 16; ++tt) out[tt] = bb + w0 * xv[tt] + w1 * xv[tt + 1] + w2 * xv[tt + 2];
}

__device__ __forceinline__ void hy_s1_item(CParams& p, int layer, int item) {
    const int cidx = item >> 3, cgp = item & 7, b = cidx / NCHK, c = cidx % NCHK;
    const int tid = opaque_tid(), j = tid & 63, tq = tid >> 6, ch = cgp * 64 + j;
    const int t0 = c * 128 + 16 * tq - 112;
    if (t0 < 0) return;
    const bf16_t* P = (const bf16_t*)(p.ws + R_PMIX);
    const float* cw = p.in[12] + layer * 3 * 1536; const float* cbias = p.in[13] + layer * 1536;
    float x1[16], vv[16];
    conv3_16(P, cw, cbias, b, t0, 1024 + 512 + ch, x1); conv3_16(P, cw, cbias, b, t0, 1024 + 1024 + ch, vv);
    bf16_t* UT = (bf16_t*)(p.ws + R_UT) + ((size_t)ch * 2 + b) * TF + (t0 + FOFF);
    u32x4 wa, wb;
    wa.x = pk2(x1[0] * vv[0], x1[1] * vv[1]); wa.y = pk2(x1[2] * vv[2], x1[3] * vv[3]); wa.z = pk2(x1[4] * vv[4], x1[5] * vv[5]); wa.w = pk2(x1[6] * vv[6], x1[7] * vv[7]);
    wb.x = pk2(x1[8] * vv[8], x1[9] * vv[9]); wb.y = pk2(x1[10] * vv[10], x1[11] * vv[11]); wb.z = pk2(x1[12] * vv[12], x1[13] * vv[13]); wb.w = pk2(x1[14] * vv[14], x1[15] * vv[15]);
    *(u32x4*)UT = wa; *(u32x4*)(UT + 8) = wb;
}

__device__ __forceinline__ void hy_s3_item(CParams& p, int layer, int item) {
    const int cidx = item >> 3, cgp = item & 7, b = cidx / NCHK, c = cidx % NCHK;
    const int tid = opaque_tid(), j = tid & 63, tq = tid >> 6, ch = cgp * 64 + j;
    const int t0 = c * 128 + 16 * tq - 112;
    bf16_t* Z = (bf16_t*)(p.ws + OFF_Z);
    if (t0 < 0) {
#pragma unroll
        for (int tt = 0; tt < 16; ++tt) Z[(size_t)row_bci(b, c, 16 * tq + tt) * D + 512 + ch] = 0;
        return; }
    const bf16_t* P = (const bf16_t*)(p.ws + R_PMIX);
    const float* cw = p.in[12] + layer * 3 * 1536; const float* cbias = p.in[13] + layer * 1536;
    float x0[16];
    conv3_16(P, cw, cbias, b, t0, 1024 + ch, x0);
    const bf16_t* YT = (const bf16_t*)(p.ws + R_YT) + ((size_t)ch * 2 + b) * TF + (t0 + FOFF);
    const u32x4 ya = *(const u32x4*)YT, yb = *(const u32x4*)(YT + 8);
#pragma unroll
    for (int tt = 0; tt < 16; ++tt) { const unsigned wv = (tt < 8) ? ya[tt >> 1] : yb[(tt - 8) >> 1];
        const float y = (tt & 1) ? __uint_as_float(wv & 0xffff0000u) : __uint_as_float(wv << 16);
        Z[(size_t)row_bci(b, c, 16 * tq + tt) * D + 512 + ch] = (bf16_t)f2bf(x0[tt] * y); }
}

__device__ __forceinline__ bf16x8 toep_frag(const LAS unsigned* G32, int e) {
    const int d = e >> 1; const unsigned sh = (unsigned)(e & 1) * 16u;
    const unsigned w0 = G32[d], w1 = G32[d + 1], w2 = G32[d + 2], w3 = G32[d + 3], w4 = G32[d + 4];
    u32x4 r; r.x = __builtin_amdgcn_alignbit(w1, w0, sh); r.y = __builtin_amdgcn_alignbit(w2, w1, sh); r.z = __builtin_amdgcn_alignbit(w3, w2, sh); r.w = __builtin_amdgcn_alignbit(w4, w3, sh);
    return __builtin_bit_cast(bf16x8, r);
}

__device__ __forceinline__ bf16x8 toep_frag2(const LAS unsigned* q, unsigned sh) {
    const unsigned w0 = q[0], w1 = q[1], w2 = q[2], w3 = q[3], w4 = q[4];
    u32x4 r; r.x = __builtin_amdgcn_alignbit(w1, w0, sh); r.y = __builtin_amdgcn_alignbit(w2, w1, sh); r.z = __builtin_amdgcn_alignbit(w3, w2, sh); r.w = __builtin_amdgcn_alignbit(w4, w3, sh);
    return __builtin_bit_cast(bf16x8, r);
}

__device__ __forceinline__ void hy_conv_item(CParams& p, int layer, int ch, LAS unsigned char* lds) {
    LAS bf16_t* GRl = (LAS bf16_t*)lds; LAS bf16_t* UL = GRl + GRN; LAS float* PART = (LAS float*)(lds + GRN * 2 + 2 * UBT * 2);
    const int tid = opaque_tid(), lane = tid & 63, wave = tid >> 6, r = lane & 15, h = lane >> 4;
    const bf16_t* GRg = (const bf16_t*)(p.ws + R_GR) + (size_t)ch * GRN;
    const bf16_t* UTg = (const bf16_t*)(p.ws + R_UT) + (size_t)ch * 2 * TF;
    bf16_t* YTg = (bf16_t*)(p.ws + R_YT) + (size_t)ch * 2 * TF;
    const float bias = p.in[20][layer * W + ch];
    __syncthreads();
    for (int q = tid; q < GRN / 8; q += 512) { u32x4 v = *(const u32x4*)(GRg + q * 8);
        if (q < 254 || q >= 2306) v = (u32x4){0u, 0u, 0u, 0u}; else if (q == 254) v.x &= 0xffff0000u;
        *(LAS u32x4*)(GRl + q * 8) = v; }
    for (int q = tid; q < 2 * (TF / 8); q += 512) { const int bt = q / (TF / 8), f0 = (q % (TF / 8)) * 8;
        u32x4 v = (u32x4){0u, 0u, 0u, 0u}; if (f0 >= FOFF) v = *(const u32x4*)(UTg + (size_t)bt * TF + f0);
        *(LAS u32x4*)(UL + bt * UBT + ((f0 >> 7) + 15) * UBLK + (f0 & 127)) = v; }
    for (int q = tid; q < 2 * 30 * 17; q += 512) { const int bt = q / 510, rem = q % 510, blk = rem / 17, part = rem % 17; const int bi = blk < 15 ? blk : 65 + blk;
        *(LAS u32x4*)(UL + bt * UBT + bi * UBLK + part * 8) = (u32x4){0u, 0u, 0u, 0u}; }
    __syncthreads();
    const LAS unsigned* G32 = (const LAS unsigned*)GRl;
    { const int bt = wave >> 2, I0 = 1 + 16 * (wave & 3);
      f32x4 acc[8];
#pragma unroll
      for (int mi = 0; mi < 8; ++mi) acc[mi] = (f32x4){0.f, 0.f, 0.f, 0.f};
      const LAS bf16_t* ub = UL + bt * UBT + (I0 + r + 15) * UBLK + 8 * h;
      const int x0 = 8 * h - r + GROFF - 112;
      const unsigned sh = (unsigned)(x0 & 1) * 16u;
      const LAS unsigned* gq = G32 + (x0 >> 1) - 64 * (I0 + 15);
      const LAS bf16_t* uq = ub - (I0 + 15) * UBLK;
      bf16x8 R[16];
#pragma unroll
      for (int mm = 0; mm < 6; ++mm) R[(mm - 7) & 15] = toep_frag2(gq + 8 * mm, sh);
#define HY_STEP(PAR) { \
          _Pragma("unroll") for (int mm = 6; mm < 14; ++mm) R[(mm - 7 + 8 * (PAR)) & 15] = toep_frag2(gq + 8 * mm, sh); \
          _Pragma("unroll") for (int ks = 0; ks < 4; ++ks) { const bf16x8 B = *(const LAS bf16x8*)(uq + 32 * ks); \
              _Pragma("unroll") for (int mi = 0; mi < 8; ++mi) acc[mi] = __builtin_amdgcn_mfma_f32_16x16x32_bf16(R[(2 * ks - mi + 8 * (PAR)) & 15], B, acc[mi], 0, 0, 0); } \
          gq += 64; uq += UBLK; }
      for (int sp = 0; sp < 40; ++sp) { HY_STEP(0) HY_STEP(1) }
#undef HY_STEP
      const int I = I0 + r;
#pragma unroll
      for (int mi = 0; mi < 8; ++mi) { const int i = 16 * mi + 4 * h; const int f = 128 * I + i;
          const LAS bf16_t* up = UL + bt * UBT + (I + 15) * UBLK + i;
          u32x2 w; w.x = pk2(acc[mi][0] + bias * bf2f(up[0]), acc[mi][1] + bias * bf2f(up[1])); w.y = pk2(acc[mi][2] + bias * bf2f(up[2]), acc[mi][3] + bias * bf2f(up[3]));
          *(u32x2*)(YTg + (size_t)bt * TF + f) = w; }
    }
    if (layer == 0) { f32x4 am[8];
#pragma unroll
      for (int mi = 0; mi < 8; ++mi) am[mi] = (f32x4){0.f, 0.f, 0.f, 0.f};
      const int Lb = -64 + 8 * wave, Le = Lb + 8 + (wave == 7 ? 1 : 0);
      const int x0 = 8 * h - r + GROFF - 112; const unsigned sh = (unsigned)(x0 & 1) * 16u;
      for (int L = Lb; L < Le; ++L) {
          bf16x8 A[14];
          const LAS unsigned* gq = G32 + (x0 >> 1) - 64 * L;
#pragma unroll
          for (int mm = 0; mm < 14; ++mm) A[mm] = toep_frag2(gq + 8 * mm, sh);
#pragma unroll
          for (int ks = 0; ks < 4; ++ks) { const bf16x8 B = *(const LAS bf16x8*)(UL + (r & 1) * UBT + (15 - L) * UBLK + 32 * ks + 8 * h);
#pragma unroll
              for (int mi = 0; mi < 8; ++mi) am[mi] = __builtin_amdgcn_mfma_f32_16x16x32_bf16(A[2 * ks - mi + 7], B, am[mi], 0, 0, 0); }
      }
      if (r < 2) {
#pragma unroll
          for (int mi = 0; mi < 8; ++mi)
#pragma unroll
              for (int q = 0; q < 4; ++q) PART[(wave * 2 + r) * 128 + 16 * mi + 4 * h + q] = am[mi][q]; }
    }
    __syncthreads();
    if (layer == 0 && tid < 32) { const int bt = tid >> 4, i = 112 + (tid & 15); float s = 0.f;
#pragma unroll
        for (int w8 = 0; w8 < 8; ++w8) s += PART[(w8 * 2 + bt) * 128 + i];
        const float uu = bf2f(UL[bt * UBT + 15 * UBLK + i]); YTg[(size_t)bt * TF + i] = (bf16_t)f2bf(s + bias * uu); }
}

__device__ __forceinline__ void gla_decode(int w, int& grp, int& c) { if (w < 512) { grp = w >> 6; c = 1 + (w & 63); } else { grp = w - 512; c = 0; } }

__device__ __forceinline__ unsigned cvt_pk_bf16(float lo, float hi) { return pk2(lo, hi); }
__device__ __forceinline__ bf16x8 pack8(const f32x4 a, const f32x4 b) { u32x4 w; w.x = cvt_pk_bf16(a[0], a[1]); w.y = cvt_pk_bf16(a[2], a[3]); w.z = cvt_pk_bf16(b[0], b[1]); w.w = cvt_pk_bf16(b[2], b[3]); return __builtin_bit_cast(bf16x8, w); }
constexpr int GL_QS = 136, GL_TS = 40;
constexpr int GL_QT = 0, GL_KT = 32 * GL_QS * 2, GL_KHT = 2 * 32 * GL_QS * 2, GL_VT = GL_KHT + 128 * GL_TS * 2, GL_GS = GL_VT + 128 * GL_TS * 2, GL_HEAD = GL_GS + 512;

__device__ __forceinline__ float scan32_add(float v) {
    v += __int_as_float(__builtin_amdgcn_update_dpp(0, __float_as_int(v), 0x111, 0xf, 0xf, false));
    v += __int_as_float(__builtin_amdgcn_update_dpp(0, __float_as_int(v), 0x112, 0xf, 0xf, false));
    v += __int_as_float(__builtin_amdgcn_update_dpp(0, __float_as_int(v), 0x114, 0xf, 0xf, false));
    v += __int_as_float(__builtin_amdgcn_update_dpp(0, __float_as_int(v), 0x118, 0xf, 0xf, false));
    v += __int_as_float(__builtin_amdgcn_update_dpp(0, __float_as_int(v), 0x142, 0xa, 0xf, false));
    return v;
}
template <bool PH3>
__device__ __forceinline__ void gla_item(CParams& p, int layer, int w, LAS unsigned char* lds) {
    int grp, c; gla_decode(w, grp, c);
    const int br = grp >> 2, dir = (grp >> 1) & 1, b = grp & 1, item = grp * NCHK + c;
    const bool incl = !(br == 0 && dir == 1);
    const int tid = opaque_tid(), lane = tid & 63, wave = tid >> 6, hd = wave >> 1, vh = wave & 1, r = lane & 15, h = lane >> 4;
    LAS unsigned char* hb = lds + hd * GL_HEAD;
    const bf16_t* P = (const bf16_t*)(p.ws + R_PMIX);
    const f32x2* RT = (const f32x2*)(p.ws + OFF_ROPE);
    bf16_t* U = (bf16_t*)(p.ws + R_U) + (size_t)item * 65536 + (size_t)(hd * 128 + 4 * h) * 128 + 64 * vh + r;
    f32x4 S[8][4];
#pragma unroll
    for (int dt = 0; dt < 8; ++dt)
#pragma unroll
        for (int vt = 0; vt < 4; ++vt) {
            if (PH3) {
#pragma unroll
                for (int q = 0; q < 4; ++q) S[dt][vt][q] = bf2f(U[(16 * dt + q) * 128 + 16 * vt]);
            } else S[dt][vt] = (f32x4){0.f, 0.f, 0.f, 0.f}; }
    const int fcol = dir ? 5632 : 5120;
    bf16_t* Og = (bf16_t*)(p.ws + R_O) + (size_t)(br * 2 + dir) * MP * W;
    const int nsb = (c == 0) ? 1 : 4;
    for (int sbi = 0; sbi < nsb; ++sbi) {
        const int sb = (c == 0) ? 3 : (dir ? 3 - sbi : sbi);
        __syncthreads();
        {
            const int ip = lane & 31, hw = (lane >> 5) + 2 * wave;
            const int i = sb * 32 + (dir ? 31 - ip : ip), t = c * 128 + i - 112; const bool valid = t >= 0;
            const bf16_t* prow = P + (size_t)row_bci(b, c, i) * NMIX;
#pragma unroll 2
            for (int itc = 0; itc < 4; ++itc) {
                const int d0 = 8 * (hw + 16 * itc), shd = d0 >> 7, sdl = d0 & 127;
                LAS unsigned char* hs = lds + shd * GL_HEAD;
                float q[8], k[8], v[8], l[8];
                if (br == 0) {
                    const u32x4 kr = *(const u32x4*)(prow + 3072 + d0), kp = *(const u32x4*)(prow + 3072 + (d0 ^ 64)), vr = *(const u32x4*)(prow + 3584 + d0);
                    u32x4 qr = (u32x4){0u, 0u, 0u, 0u}, qp = (u32x4){0u, 0u, 0u, 0u};
                    if (PH3) { qr = *(const u32x4*)(prow + 2560 + d0); qp = *(const u32x4*)(prow + 2560 + (d0 ^ 64)); }
                    const f32x4* rt = (const f32x4*)(RT + (size_t)(valid ? t : 0) * 64 + (sdl & 63));
                    const f32x4 c0 = rt[0], c1 = rt[1], c2 = rt[2], c3 = rt[3];
                    const float cs[16] = {c0[0], c0[1], c0[2], c0[3], c1[0], c1[1], c1[2], c1[3], c2[0], c2[1], c2[2], c2[3], c3[0], c3[1], c3[2], c3[3]};
                    const float sgn = (sdl < 64) ? -1.f : 1.f; const float lg = log1pf(-exp2f(-5.0f - (float)shd));
#pragma unroll
                    for (int e = 0; e < 8; ++e) { const unsigned wkr = kr[e >> 1], wkp = kp[e >> 1], wvr = vr[e >> 1], wqr = qr[e >> 1], wqp = qp[e >> 1];
                        const float fkr = (e & 1) ? __uint_as_float(wkr & 0xffff0000u) : __uint_as_float(wkr << 16), fkp = (e & 1) ? __uint_as_float(wkp & 0xffff0000u) : __uint_as_float(wkp << 16);
                        const float fqr = (e & 1) ? __uint_as_float(wqr & 0xffff0000u) : __uint_as_float(wqr << 16), fqp = (e & 1) ? __uint_as_float(wqp & 0xffff0000u) : __uint_as_float(wqp << 16);
                        k[e] = (fkr * cs[2 * e] + sgn * fkp * cs[2 * e + 1]) * 0.08838834764831845f; q[e] = fqr * cs[2 * e] + sgn * fqp * cs[2 * e + 1];
                        v[e] = (e & 1) ? __uint_as_float(wvr & 0xffff0000u) : __uint_as_float(wvr << 16); l[e] = lg; }
                } else {
                    const u32x4 fr = *(const u32x4*)(prow + fcol + d0), vr = *(const u32x4*)(prow + 6144 + d0);
                    u32x4 qr = (u32x4){0u, 0u, 0u, 0u}; if (PH3) qr = *(const u32x4*)(prow + 4608 + d0);
                    const f32x4 la = *(const f32x4*)((const float*)(p.ws + OFF_LBT) + d0), lb4 = *(const f32x4*)((const float*)(p.ws + OFF_LBT) + d0 + 4);
#pragma unroll
                    for (int e = 0; e < 8; ++e) { const unsigned wfr = fr[e >> 1], wvr = vr[e >> 1], wqr = qr[e >> 1];
                        const float ffr = (e & 1) ? __uint_as_float(wfr & 0xffff0000u) : __uint_as_float(wfr << 16), fqr = (e & 1) ? __uint_as_float(wqr & 0xffff0000u) : __uint_as_float(wqr << 16);
                        const float lbv = e < 4 ? la[e & 3] : lb4[e & 3];
                        const float f = lbv + (1.0f - lbv) * sigm(ffr); l[e] = __logf(f); k[e] = 1.0f - f; q[e] = fqr * sigm(fqr);
                        v[e] = (e & 1) ? __uint_as_float(wvr & 0xffff0000u) : __uint_as_float(wvr << 16); }
                }
                if (!valid) {
#pragma unroll
                    for (int e = 0; e < 8; ++e) { q[e] = 0.f; k[e] = 0.f; v[e] = 0.f; l[e] = 0.f; } }
                float eb[8], enb[8];
                if (br == 0) {
                    const float l0 = scan32_add(l[0]); const float a0 = __expf(l0), b0 = __expf(fminf(-l0, 80.0f));
#pragma unroll
                    for (int e = 0; e < 8; ++e) { l[e] = l0; eb[e] = a0; enb[e] = b0; }
                } else {
#pragma unroll
                    for (int e = 0; e < 8; ++e) { l[e] = scan32_add(l[e]); enb[e] = __expf(fminf(-l[e], 80.0f)); eb[e] = PH3 ? __expf(l[e]) : 0.f; }
                }
                float kt[8];
#pragma unroll
                for (int e = 0; e < 8; ++e) kt[e] = k[e] * enb[e];
                LAS bf16_t* sKHT = (LAS bf16_t*)(hs + GL_KHT); LAS bf16_t* sVT = (LAS bf16_t*)(hs + GL_VT);
                if (PH3) { u32x4 wq, wk;
                    wq.x = cvt_pk_bf16(q[0] * eb[0], q[1] * eb[1]); wq.y = cvt_pk_bf16(q[2] * eb[2], q[3] * eb[3]);
                    wq.z = cvt_pk_bf16(q[4] * eb[4], q[5] * eb[5]); wq.w = cvt_pk_bf16(q[6] * eb[6], q[7] * eb[7]);
                    wk.x = cvt_pk_bf16(kt[0], kt[1]); wk.y = cvt_pk_bf16(kt[2], kt[3]); wk.z = cvt_pk_bf16(kt[4], kt[5]); wk.w = cvt_pk_bf16(kt[6], kt[7]);
                    *(LAS u32x4*)((LAS bf16_t*)(hs + GL_QT) + ip * GL_QS + sdl) = wq; *(LAS u32x4*)((LAS bf16_t*)(hs + GL_KT) + ip * GL_QS + sdl) = wk; }
#pragma unroll
                for (int e = 0; e < 8; ++e) { sKHT[(sdl + e) * GL_TS + ip] = (bf16_t)f2bf(kt[e]); sVT[(sdl + e) * GL_TS + ip] = (bf16_t)f2bf(v[e]); }
                if (ip == 31) { LAS float* sGS = (LAS float*)(hs + GL_GS); LAS float* LT = (LAS float*)(lds + 4 * GL_HEAD);
#pragma unroll
                    for (int e = 0; e < 8; ++e) { sGS[sdl + e] = __expf(l[e]); LT[d0 + e] = (sbi == 0 ? 0.f : LT[d0 + e]) + l[e]; } }
            }
        }
        __syncthreads();
        const LAS bf16_t* QT = (const LAS bf16_t*)(hb + GL_QT); const LAS bf16_t* KT = (const LAS bf16_t*)(hb + GL_KT);
        const LAS bf16_t* KHT = (const LAS bf16_t*)(hb + GL_KHT); const LAS bf16_t* VT = (const LAS bf16_t*)(hb + GL_VT); const LAS float* GS = (const LAS float*)(hb + GL_GS);
        if (PH3) {
            f32x4 X[2][2];
#pragma unroll
            for (int a = 0; a < 2; ++a)
#pragma unroll
                for (int bq = 0; bq < 2; ++bq) X[a][bq] = (f32x4){0.f, 0.f, 0.f, 0.f};
#pragma unroll
            for (int kk = 0; kk < 4; ++kk) { bf16x8 aK[2], bQ[2];
#pragma unroll
                for (int t2 = 0; t2 < 2; ++t2) { aK[t2] = *(const LAS bf16x8*)(KT + (16 * t2 + r) * GL_QS + 32 * kk + 8 * h); bQ[t2] = *(const LAS bf16x8*)(QT + (16 * t2 + r) * GL_QS + 32 * kk + 8 * h); }
#pragma unroll
                for (int jt = 0; jt < 2; ++jt)
#pragma unroll
                    for (int it = 0; it < 2; ++it) X[jt][it] = __builtin_amdgcn_mfma_f32_16x16x32_bf16(aK[jt], bQ[it], X[jt][it], 0, 0, 0); }
            bf16x8 PA[2];
#pragma unroll
            for (int it = 0; it < 2; ++it) { f32x4 lo, hi; const int ipx = 16 * it + r;
#pragma unroll
                for (int q = 0; q < 4; ++q) { const int j0 = 4 * h + q, j1 = 16 + 4 * h + q;
                    lo[q] = (incl ? (j0 <= ipx) : (j0 < ipx)) ? X[0][it][q] : 0.f; hi[q] = (incl ? (j1 <= ipx) : (j1 < ipx)) ? X[1][it][q] : 0.f; }
                PA[it] = pack8(lo, hi); }
            f32x4 O[2][4];
#pragma unroll
            for (int vt = 0; vt < 4; ++vt) { const LAS bf16_t* vp = VT + (64 * vh + 16 * vt + r) * GL_TS;
                const u32x2 lo = *(const LAS u32x2*)(vp + 4 * h), hi = *(const LAS u32x2*)(vp + 16 + 4 * h);
                const bf16x8 BV = __builtin_bit_cast(bf16x8, ((u32x4){lo.x, lo.y, hi.x, hi.y}));
#pragma unroll
                for (int it = 0; it < 2; ++it) O[it][vt] = __builtin_amdgcn_mfma_f32_16x16x32_bf16(PA[it], BV, (f32x4){0.f, 0.f, 0.f, 0.f}, 0, 0, 0); }
#pragma unroll
            for (int kk = 0; kk < 4; ++kk) { bf16x8 aQ[2];
#pragma unroll
                for (int it = 0; it < 2; ++it) { const LAS bf16_t* qp = QT + (16 * it + r) * GL_QS + 32 * kk;
                    const u32x2 lo = *(const LAS u32x2*)(qp + 4 * h), hi = *(const LAS u32x2*)(qp + 16 + 4 * h);
                    aQ[it] = __builtin_bit_cast(bf16x8, ((u32x4){lo.x, lo.y, hi.x, hi.y})); }
#pragma unroll
                for (int vt = 0; vt < 4; ++vt) { const bf16x8 BS = pack8(S[2 * kk][vt], S[2 * kk + 1][vt]);
#pragma unroll
                    for (int it = 0; it < 2; ++it) O[it][vt] = __builtin_amdgcn_mfma_f32_16x16x32_bf16(aQ[it], BS, O[it][vt], 0, 0, 0); } }
#pragma unroll
            for (int it = 0; it < 2; ++it)
#pragma unroll
                for (int q = 0; q < 4; ++q) { const int ipx = 16 * it + 4 * h + q, i = sb * 32 + (dir ? 31 - ipx : ipx);
                    if ((c * 128 + i - 112) >= 0) { bf16_t* op = Og + (size_t)row_bci(b, c, i) * W + hd * 128 + 64 * vh + r;
#pragma unroll
                        for (int vt = 0; vt < 4; ++vt) op[16 * vt] = (bf16_t)f2bf(O[it][vt][q]); } }
        }
        {
            bf16x8 bV[4];
#pragma unroll
            for (int vt = 0; vt < 4; ++vt) bV[vt] = *(const LAS bf16x8*)(VT + (64 * vh + 16 * vt + r) * GL_TS + 8 * h);
#pragma unroll
            for (int dt = 0; dt < 8; ++dt) { const f32x4 g4 = *(const LAS f32x4*)(GS + 16 * dt + 4 * h); const bf16x8 aKH = *(const LAS bf16x8*)(KHT + (16 * dt + r) * GL_TS + 8 * h);
#pragma unroll
                for (int vt = 0; vt < 4; ++vt) S[dt][vt] = __builtin_amdgcn_mfma_f32_16x16x32_bf16(aKH, bV[vt], S[dt][vt], 0, 0, 0) * g4; }
        }
    }
    if (!PH3) {
#pragma unroll
        for (int dt = 0; dt < 8; ++dt)
#pragma unroll
            for (int vt = 0; vt < 4; ++vt)
#pragma unroll
                for (int q = 0; q < 4; ++q) U[(16 * dt + q) * 128 + 16 * vt] = (bf16_t)f2bf(S[dt][vt][q]);
        __syncthreads();
        ((float*)(p.ws + R_GG))[(size_t)item * 512 + tid] = __expf(((const LAS float*)(lds + 4 * GL_HEAD))[tid]);
    }
}

__device__ __forceinline__ void gla_carry(CParams& p) {
    const int gidx = blockIdx.x * 512 + opaque_tid();
    if (gidx >= 8 * 16384) return;
    const int grp = gidx >> 14, e4 = gidx & 16383, dir = (grp >> 1) & 1, hdd = (e4 * 4) >> 7;
    bf16_t* U = (bf16_t*)(p.ws + R_U) + (size_t)grp * NCHK * 65536 + e4 * 4; const float* GG = (const float*)(p.ws + R_GG) + (size_t)grp * NCHK * 512 + hdd;
    f32x4 S = (f32x4){0.f, 0.f, 0.f, 0.f};
    for (int s0 = 0; s0 < NCHK; s0 += 5) {
        u32x2 u[5]; float g[5];
#pragma unroll
        for (int q = 0; q < 5; ++q) { const int c = dir ? NCHK - 1 - (s0 + q) : (s0 + q); u[q] = *(const u32x2*)(U + (size_t)c * 65536); g[q] = GG[(size_t)c * 512]; }
#pragma unroll
        for (int q = 0; q < 5; ++q) { const int c = dir ? NCHK - 1 - (s0 + q) : (s0 + q);
            u32x2 w; w.x = pk2(S[0], S[1]); w.y = pk2(S[2], S[3]); *(u32x2*)(U + (size_t)c * 65536) = w;
            const f32x4 uv = (f32x4){__uint_as_float(u[q].x << 16), __uint_as_float(u[q].x & 0xffff0000u), __uint_as_float(u[q].y << 16), __uint_as_float(u[q].y & 0xffff0000u)};
            S = S * g[q] + uv; }
    }
}

__device__ __forceinline__ float row16_sum(float v) {
    v += __int_as_float(__builtin_amdgcn_update_dpp(0, __float_as_int(v), 0x121, 0xf, 0xf, false));
    v += __int_as_float(__builtin_amdgcn_update_dpp(0, __float_as_int(v), 0x122, 0xf, 0xf, false));
    v += __int_as_float(__builtin_amdgcn_update_dpp(0, __float_as_int(v), 0x124, 0xf, 0xf, false));
    v += __int_as_float(__builtin_amdgcn_update_dpp(0, __float_as_int(v), 0x128, 0xf, 0xf, false));
    return v;
}
__device__ __forceinline__ void gla_s4(CParams& p) {
    const int tid0 = opaque_tid(); const int lane = tid0 & 63, gw = blockIdx.x * 8 + (tid0 >> 6), NW = gridDim.x * 8;
    const bf16_t* P = (const bf16_t*)(p.ws + R_PMIX); const bf16_t* O = (const bf16_t*)(p.ws + R_O); bf16_t* Z = (bf16_t*)(p.ws + OFF_Z);
    for (int it = gw; it < MP * 2; it += NW) { const int row = it >> 1, br = it & 1;
        bf16_t* zp = Z + (size_t)row * D + 1024 + br * W + lane * 8;
        if (row >= MX && ((row - MX) & 127) < 112) { *(u32x4*)zp = (u32x4){0u, 0u, 0u, 0u}; continue; }
        const u32x4 of = *(const u32x4*)(O + ((size_t)(br * 2 + 0) * MP + row) * W + lane * 8), ob = *(const u32x4*)(O + ((size_t)(br * 2 + 1) * MP + row) * W + lane * 8);
        const u32x4 gv = *(const u32x4*)(P + (size_t)row * NMIX + (br ? 6656 : 4096) + lane * 8);
        float o[8], g[8];
#pragma unroll
        for (int q = 0; q < 4; ++q) { o[2 * q] = __uint_as_float(of[q] << 16) + __uint_as_float(ob[q] << 16); o[2 * q + 1] = __uint_as_float(of[q] & 0xffff0000u) + __uint_as_float(ob[q] & 0xffff0000u);
            g[2 * q] = __uint_as_float(gv[q] << 16); g[2 * q + 1] = __uint_as_float(gv[q] & 0xffff0000u); }
        float s = 0.f;
#pragma unroll
        for (int q = 0; q < 8; ++q) s += o[q];
        s = row16_sum(s);
        const float mu = br ? 0.f : s * (1.0f / 128.0f);
        float s2 = 0.f;
#pragma unroll
        for (int q = 0; q < 8; ++q) { o[q] -= mu; s2 += o[q] * o[q]; }
        s2 = row16_sum(s2);
        const float rs = 1.0f / sqrtf(s2 * (1.0f / 128.0f) + EPS);
        u32x4 w;
#pragma unroll
        for (int q = 0; q < 4; ++q) w[q] = pk2(o[2 * q] * rs * siluf(g[2 * q]), o[2 * q + 1] * rs * siluf(g[2 * q + 1]));
        *(u32x4*)zp = w; }
}


__device__ __forceinline__ void skinny_acc(const bf16_t* A, int lda, const bf16_t* Wrow, int ldw, int k_begin, int nk, int r, int h, f32x4 (&acc)[2]) {
    const bf16_t* a0 = A + (size_t)(MX + 112 + r) * lda + 8 * h + k_begin;
    const bf16_t* a1 = A + (size_t)(MX + 128 + 112 + r) * lda + 8 * h + k_begin;
    const bf16_t* bp = Wrow + (size_t)r * ldw + 8 * h + k_begin;
#pragma unroll 8
    for (int ks = 0; ks < nk; ++ks) { const bf16x8 x0 = *(const bf16x8*)(a0 + 32 * ks), x1 = *(const bf16x8*)(a1 + 32 * ks), bb = *(const bf16x8*)(bp + 32 * ks);
        acc[0] = __builtin_amdgcn_mfma_f32_16x16x32_bf16(x0, bb, acc[0], 0, 0, 0); acc[1] = __builtin_amdgcn_mfma_f32_16x16x32_bf16(x1, bb, acc[1], 0, 0, 0); }
}
#define SK_HEAD const int tid = opaque_tid(), lane = tid & 63, wave = tid >> 6, r = lane & 15, h = lane >> 4; LAS float* part = (LAS float*)lds; \
    const int e_mt = tid >> 8, e_q = (tid >> 6) & 3, e_h = (tid & 63) >> 4, e_r = tid & 15; const size_t e_row = (size_t)(MX + 128 * e_mt + 112 + 4 * e_h + e_q);
__device__ __forceinline__ void sk_put(LAS float* part, int wave, int lane, const f32x4 (&acc)[2]) {
#pragma unroll
    for (int mt = 0; mt < 2; ++mt)
#pragma unroll
        for (int q = 0; q < 4; ++q) part[wave * 512 + (mt * 4 + q) * 64 + lane] = acc[mt][q];
}
__device__ __forceinline__ float sk_sum8(const LAS float* part, int tid) { float s = 0.f;
#pragma unroll
    for (int w8 = 0; w8 < 8; ++w8) s += part[w8 * 512 + tid];
    return s; }
__device__ __forceinline__ void skinny_in(CParams& p, int mode, LAS unsigned char* lds) {
    SK_HEAD
    const bf16_t* NB = (const bf16_t*)(p.ws + OFF_NB); const bf16_t* WIN = (const bf16_t*)(p.ws + OFF_WIN) + (size_t)(mode ? NMIX : 0) * D;
    const int ntile = mode ? NGATE / 16 : NMIX / 16;
    for (int t0 = blockIdx.x; t0 < ntile; t0 += 2 * gridDim.x) { const int t1 = t0 + gridDim.x; const bool two = t1 < ntile; const int t1c = two ? t1 : t0;
        f32x4 aA[2] = {(f32x4){0.f, 0.f, 0.f, 0.f}, (f32x4){0.f, 0.f, 0.f, 0.f}}, aB[2] = {(f32x4){0.f, 0.f, 0.f, 0.f}, (f32x4){0.f, 0.f, 0.f, 0.f}};
        __syncthreads();
        { const int kb = wave * (D / 8);
          const bf16_t* a0 = NB + (size_t)(MX + 112 + r) * D + 8 * h + kb; const bf16_t* a1 = NB + (size_t)(MX + 128 + 112 + r) * D + 8 * h + kb;
          const bf16_t* b0 = WIN + (size_t)(t0 * 16 + r) * D + 8 * h + kb; const bf16_t* b1 = WIN + (size_t)(t1c * 16 + r) * D + 8 * h + kb;
#pragma unroll
          for (int ks = 0; ks < D / 256; ++ks) { const bf16x8 x0 = *(const bf16x8*)(a0 + 32 * ks), x1 = *(const bf16x8*)(a1 + 32 * ks), w0 = *(const bf16x8*)(b0 + 32 * ks), w1 = *(const bf16x8*)(b1 + 32 * ks);
              aA[0] = __builtin_amdgcn_mfma_f32_16x16x32_bf16(x0, w0, aA[0], 0, 0, 0); aA[1] = __builtin_amdgcn_mfma_f32_16x16x32_bf16(x1, w0, aA[1], 0, 0, 0);
              aB[0] = __builtin_amdgcn_mfma_f32_16x16x32_bf16(x0, w1, aB[0], 0, 0, 0); aB[1] = __builtin_amdgcn_mfma_f32_16x16x32_bf16(x1, w1, aB[1], 0, 0, 0); } }
        sk_put(part, wave, lane, aA); sk_put(part + 4096, wave, lane, aB);
        __syncthreads();
        const float sA = sk_sum8(part, tid), sB = sk_sum8(part + 4096, tid);
        if (mode) { bf16_t* G = (bf16_t*)(p.ws + R_G); G[e_row * NGATE + t0 * 16 + e_r] = (bf16_t)f2bf(sA); if (two) G[e_row * NGATE + t1 * 16 + e_r] = (bf16_t)f2bf(sB); }
        else { bf16_t* P = (bf16_t*)(p.ws + R_PMIX); P[e_row * NMIX + t0 * 16 + e_r] = (bf16_t)f2bf(sA); if (two) P[e_row * NMIX + t1 * 16 + e_r] = (bf16_t)f2bf(sB); } }
}
__device__ __forceinline__ void skinny_branch(CParams& p, LAS unsigned char* lds) {
    SK_HEAD
    const bf16_t* Z = (const bf16_t*)(p.ws + OFF_Z); const bf16_t* WBO = (const bf16_t*)(p.ws + OFF_WBO); const bf16_t* G = (const bf16_t*)(p.ws + R_G); bf16_t* MB = (bf16_t*)(p.ws + R_MB);
    const int z = wave >> 1, kh = wave & 1;
    for (int tile = blockIdx.x; tile < D / 16; tile += gridDim.x) { f32x4 acc[2] = {(f32x4){0.f, 0.f, 0.f, 0.f}, (f32x4){0.f, 0.f, 0.f, 0.f}};
        __syncthreads();
        skinny_acc(Z + z * W, D, WBO + (size_t)z * D * W + (size_t)tile * 16 * W, W, kh * (W / 2), W / 64, r, h, acc);
        sk_put(part, wave, lane, acc);
        __syncthreads();
        float tot = 0.f;
#pragma unroll
        for (int zz = 0; zz < 4; ++zz) tot += sigm(bf2f(G[e_row * NGATE + zz * D + tile * 16 + e_r])) * (part[(2 * zz) * 512 + tid] + part[(2 * zz + 1) * 512 + tid]);
        MB[e_row * D + tile * 16 + e_r] = (bf16_t)f2bf(tot); }
}
__device__ __forceinline__ void skinny_resid(CParams& p, const bf16_t* A, int lda, const bf16_t* Wt, int K, LAS unsigned char* lds) {
    SK_HEAD
    float* H = (float*)(p.ws + OFF_H);
    for (int tile = blockIdx.x; tile < D / 16; tile += gridDim.x) { f32x4 acc[2] = {(f32x4){0.f, 0.f, 0.f, 0.f}, (f32x4){0.f, 0.f, 0.f, 0.f}};
        __syncthreads();
        skinny_acc(A, lda, Wt + (size_t)tile * 16 * K, K, wave * (K / 8), K / 256, r, h, acc);
        sk_put(part, wave, lane, acc);
        __syncthreads();
        H[e_row * D + tile * 16 + e_r] += sk_sum8(part, tid); }
}
__device__ __forceinline__ void skinny_swiglu(CParams& p, LAS unsigned char* lds) {
    SK_HEAD
    const bf16_t* NB = (const bf16_t*)(p.ws + OFF_NB); const bf16_t* WGU = (const bf16_t*)(p.ws + OFF_WGU); bf16_t* FF = (bf16_t*)(p.ws + R_FF);
    for (int tile = blockIdx.x; tile < DFF / 16; tile += gridDim.x) { const int c0 = tile * 16, wr0 = 256 * (c0 >> 7) + (c0 & 127);
        f32x4 ag[2] = {(f32x4){0.f, 0.f, 0.f, 0.f}, (f32x4){0.f, 0.f, 0.f, 0.f}}, au[2] = {(f32x4){0.f, 0.f, 0.f, 0.f}, (f32x4){0.f, 0.f, 0.f, 0.f}};
        __syncthreads();
        { const int kb = wave * (D / 8);
          const bf16_t* a0 = NB + (size_t)(MX + 112 + r) * D + 8 * h + kb; const bf16_t* a1 = NB + (size_t)(MX + 128 + 112 + r) * D + 8 * h + kb;
          const bf16_t* bg = WGU + (size_t)(wr0 + r) * D + 8 * h + kb; const bf16_t* bu = WGU + (size_t)(wr0 + 128 + r) * D + 8 * h + kb;
#pragma unroll
          for (int ks = 0; ks < D / 256; ++ks) { const bf16x8 x0 = *(const bf16x8*)(a0 + 32 * ks), x1 = *(const bf16x8*)(a1 + 32 * ks), wg = *(const bf16x8*)(bg + 32 * ks), wu = *(const bf16x8*)(bu + 32 * ks);
              ag[0] = __builtin_amdgcn_mfma_f32_16x16x32_bf16(x0, wg, ag[0], 0, 0, 0); ag[1] = __builtin_amdgcn_mfma_f32_16x16x32_bf16(x1, wg, ag[1], 0, 0, 0);
              au[0] = __builtin_amdgcn_mfma_f32_16x16x32_bf16(x0, wu, au[0], 0, 0, 0); au[1] = __builtin_amdgcn_mfma_f32_16x16x32_bf16(x1, wu, au[1], 0, 0, 0); } }
        sk_put(part, wave, lane, ag); sk_put(part + 4096, wave, lane, au);
        __syncthreads();
        const float g = sk_sum8(part, tid), u = sk_sum8(part + 4096, tid);
        FF[e_row * DFF + c0 + e_r] = (bf16_t)f2bf(siluf(g) * u); }
}


#define XB_TMO      128
#define XB_XCNT(j)  (256  + 64 * (j))
#define XB_XSUB(j)  (1280 + 64 * (j))
#define XB_XGEN(j)  (2304 + 64 * (j))
#define XB_TOP      3328
#define XB_TOPGEN   3392
#define XCD_BAR_WORDS 3456
#define XB_SPIN_CAP (1u << 22)
__device__ __forceinline__ unsigned xb_ld(unsigned* p)              { return __hip_atomic_load(p, __ATOMIC_RELAXED, __HIP_MEMORY_SCOPE_AGENT); }
__device__ __forceinline__ unsigned xb_add(unsigned* p, unsigned v) { return __hip_atomic_fetch_add(p, v, __ATOMIC_RELAXED, __HIP_MEMORY_SCOPE_AGENT); }
__device__ __forceinline__ unsigned xb_xcc_id() { return (unsigned)__builtin_amdgcn_s_getreg((3 << 11) | 20) & 0xFu; }
#define XB_SPIN(cond, bar) do { unsigned _sp = 0; while (cond) { __builtin_amdgcn_s_sleep(1); \
    if ((++_sp & 255u) == 0u) { if (xb_ld(&(bar)[XB_TMO])) break; if (_sp > XB_SPIN_CAP) { atomicAdd(&(bar)[XB_TMO], 1u); break; } } } } while (0)
struct XcdBarrier { unsigned* bar; unsigned x; volatile LAS unsigned* st; };
__device__ __forceinline__ XcdBarrier xcd_barrier_post(unsigned* bar, volatile LAS unsigned* st) {
    XcdBarrier b; b.bar = bar; b.x = xb_xcc_id(); b.st = st;
    if (threadIdx.x == 0) (void)xb_add(&bar[XB_XCNT(b.x)], 1u);
    return b;
}
__device__ __forceinline__ void xcd_barrier_complete(unsigned* bar, unsigned x, unsigned& nloc, unsigned& nx) {
    const unsigned G = gridDim.x * gridDim.y * gridDim.z;
    unsigned sum, cnt, mine, sp = 0u;
    for (;;) {
        sum = 0u; cnt = 0u; mine = 0u;
#pragma unroll
        for (unsigned j = 0; j < 16; ++j) { const unsigned c = xb_ld(&bar[XB_XCNT(j)]); sum += c; cnt += (c > 0u) ? 1u : 0u; mine = (j == x) ? c : mine; }
        if (sum == G) break;
        __builtin_amdgcn_s_sleep(1);
        if ((++sp & 255u) == 0u) { if (xb_ld(&bar[XB_TMO])) break; if (sp > XB_SPIN_CAP) { atomicAdd(&bar[XB_TMO], 1u); break; } }
    }
    nloc = mine > 0u ? mine : 1u; nx = cnt > 0u ? cnt : 1u;
}
__device__ __forceinline__ void xcd_barrier(const XcdBarrier& b) {
    asm volatile("s_waitcnt vmcnt(0)" ::: "memory");
    __syncthreads();
    if (threadIdx.x == 0) {
        unsigned* bar = b.bar;
        __builtin_amdgcn_s_waitcnt(0);
        unsigned nloc = b.st[0], nx = b.st[1];
        if (nloc == 0u) { xcd_barrier_complete(bar, b.x, nloc, nx); b.st[0] = nloc; b.st[1] = nx; }
        const unsigned old = xb_add(&bar[XB_XSUB(b.x)], 1u);
        const unsigned gen = old / nloc;
        if (old + 1u == (gen + 1u) * nloc) {
            __builtin_amdgcn_fence(__ATOMIC_RELEASE, "agent");
            asm volatile("s_waitcnt vmcnt(0)" ::: "memory");
            const unsigned og = xb_add(&bar[XB_TOP], 1u);
            const unsigned tg = og / nx;
            if (og + 1u == (tg + 1u) * nx) xb_add(&bar[XB_TOPGEN], 1u);
            else XB_SPIN(xb_ld(&bar[XB_TOPGEN]) == tg, bar);
            __builtin_amdgcn_fence(__ATOMIC_ACQUIRE, "agent");
            xb_add(&bar[XB_XGEN(b.x)], 1u);
            asm volatile("s_waitcnt vmcnt(0)" ::: "memory");
        } else {
            XB_SPIN(xb_ld(&bar[XB_XGEN(b.x)]) == gen, bar);
            __builtin_amdgcn_fence(__ATOMIC_ACQUIRE, "agent");
            asm volatile("s_waitcnt vmcnt(0)" ::: "memory");
        }
    }
    __syncthreads();
}

#ifndef WG_A
#define WG_A 4
#endif
#ifndef WG_N8
#define WG_N8 4
#endif
#ifndef PH_MASK
#define PH_MASK 0xFFFFFFF
#endif
#ifndef REP_MASK
#define REP_MASK 0
#endif
#define PH(n) for (int _r = 0, _n = 1 + ((p.rep >> (n)) & 1); _r < _n; ++_r) if (PH_MASK & (1 << (n)))
__device__ __forceinline__ CParams* kparams() { CParams* q = (CParams*)__builtin_amdgcn_kernarg_segment_ptr(); asm volatile("" : "+s"(q)); return q; }
#define p (*kparams())
__global__ void __launch_bounds__(512, 2) mega(Params p_unused) {
    extern __shared__ __attribute__((aligned(16))) unsigned char lds_raw[];
    LAS unsigned char* lds = (LAS unsigned char*)lds_raw;
    cg::grid_group grid = cg::this_grid();
    const int G = gridDim.x, bx = blockIdx.x;
    volatile LAS unsigned* xst = (volatile LAS unsigned*)(lds + 157680);
    if (threadIdx.x == 0) { xst[0] = 0u; xst[1] = 0u; }
    __syncthreads();
    const XcdBarrier xb = xcd_barrier_post((unsigned*)(p.ws + OFF_BAR), xst);
#pragma unroll 1
    for (int layer = 0; layer < 2; ++layer) {
        PH(0) phase_prep(p, layer, lds);
        if (layer == 0) grid.sync(); else xcd_barrier(xb);
        PH(1) { pg8::PlainSched S{MX / 256, NMIX / 256, G, bx, (const char*)(p.ws + OFF_NB), (const char*)(p.ws + OFF_WIN), (size_t)256 * D * 2, (size_t)256 * D * 2, WG_A};
          pg8::EpiBf16<0> E{(bf16_t*)(p.ws + R_PMIX), NMIX};
          pg8::gemm_phase(lds, D, D, D, S, E); }
        PH(18) skinny_in(p, 0, lds);
        xcd_barrier(xb);
        PH(2) for (int it = bx; it < 520; it += G) gla_item<false>(p, layer, it, lds);
        PH(3) for (int it = (G == 256 ? (bx ^ 128) : bx); it < 1040; it += G) lru_s1_item(p, layer, it, lds);
        PH(4) for (int it = (G == 256 ? (bx ^ 64) : bx); it < 1040; it += G) hy_s1_item(p, layer, it);
        xcd_barrier(xb);
        PH(5) for (int ch = bx; ch < W; ch += G) hy_conv_item(p, layer, ch, lds);
        PH(6) lru_carry(p);
        PH(6) gla_carry(p);
        xcd_barrier(xb);
        PH(7) for (int it = bx; it < 520; it += G) gla_item<true>(p, layer, it, lds);
        PH(8) for (int it = (G == 256 ? (bx ^ 128) : bx); it < 1040; it += G) lru_s3_item(p, it, lds);
        PH(9) for (int it = (G == 256 ? (bx ^ 64) : bx); it < 1040; it += G) hy_s3_item(p, layer, it);
        xcd_barrier(xb);
        PH(10) gla_s4(p);
        __syncthreads();
        PH(11) { pg8::PlainSched S{MX / 256, NGATE / 256, G, bx, (const char*)(p.ws + OFF_NB), (const char*)(p.ws + OFF_WIN) + (size_t)NMIX * D * 2, (size_t)256 * D * 2, (size_t)256 * D * 2, WG_A};
          pg8::EpiBf16<0> E{(bf16_t*)(p.ws + R_G), NGATE};
          pg8::gemm_phase(lds, D, D, D, S, E); }
        if (layer == 0) { PH(19) skinny_in(p, 1, lds); }
        xcd_barrier(xb);
        PH(12) { pg8::BranchSched S{MX / 256, D / 256, G, bx, (const char*)(p.ws + OFF_Z), (const char*)(p.ws + OFF_WBO), (size_t)256 * D * 2, (size_t)256 * W * 2, WG_N8};
          pg8::EpiBranch E{(bf16_t*)(p.ws + R_MB), (const bf16_t*)(p.ws + R_G)};
          pg8::gemm_phase(lds, D, W, W, S, E); }
        if (layer == 0) { PH(20) skinny_branch(p, lds); }
        xcd_barrier(xb);
        PH(13) { pg8::PlainSched S{MX / 256, D / 256, G, bx, (const char*)(p.ws + R_MB), (const char*)(p.ws + OFF_WOUT), (size_t)256 * D * 2, (size_t)256 * D * 2, WG_N8};
          pg8::EpiResid E{(float*)(p.ws + OFF_H), layer == 0 ? p.in[0] : (const float*)(p.ws + OFF_H)};
          pg8::gemm_phase(lds, D, D, D, S, E); }
        if (layer == 0) { PH(21) skinny_resid(p, (const bf16_t*)(p.ws + R_MB), D, (const bf16_t*)(p.ws + OFF_WOUT), D, lds); }
        xcd_barrier(xb);
        PH(14) norm_rows(p, 1, p.in[3] + layer * D, layer == 0 ? MP : MX);
        xcd_barrier(xb);
        PH(15) { pg8::PlainSched S{MX / 256, 2 * DFF / 256, G, bx, (const char*)(p.ws + OFF_NB), (const char*)(p.ws + OFF_WGU), (size_t)256 * D * 2, (size_t)256 * D * 2, 16};
          pg8::EpiSwiglu E{(bf16_t*)(p.ws + R_FF)};
          pg8::gemm_phase(lds, D, D, D, S, E); }
        if (layer == 0) { PH(22) skinny_swiglu(p, lds); }
        xcd_barrier(xb);
        PH(16) { pg8::PlainSched S{MX / 256, D / 256, G, bx, (const char*)(p.ws + R_FF), (const char*)(p.ws + OFF_WD), (size_t)256 * DFF * 2, (size_t)256 * DFF * 2, WG_N8};
          pg8::EpiResid E{(float*)(p.ws + OFF_H), (const float*)(p.ws + OFF_H)};
          pg8::gemm_phase(lds, DFF, DFF, DFF, S, E); }
        if (layer == 0) { PH(23) skinny_resid(p, (const bf16_t*)(p.ws + R_FF), DFF, (const bf16_t*)(p.ws + OFF_WD), DFF, lds); }
        xcd_barrier(xb);
    }
    PH(17) norm_rows(p, 3, p.in[27], MX);
}

#undef p
extern "C" void kernel_launch(void* const* d_in, const int* in_sizes, int n_in, void* d_out, int out_size,
                              void* d_ws, size_t ws_size, hipStream_t stream) {
    constexpr size_t kLds = 157696;
    static int grid_blocks = 0;
    if (!grid_blocks) {
        int dev = 0, cus = 0, per_cu = 0;
        hipGetDevice(&dev);
        hipDeviceGetAttribute(&cus, hipDeviceAttributeMultiprocessorCount, dev);
        hipFuncSetAttribute((const void*)mega, hipFuncAttributeMaxDynamicSharedMemorySize, (int)kLds);
        hipOccupancyMaxActiveBlocksPerMultiprocessor(&per_cu, (const void*)mega, 512, kLds);
        if (per_cu < 1) per_cu = 1;
        grid_blocks = cus * per_cu;
        if (ws_size < WS_TOTAL || n_in != 28) { fprintf(stderr, "kernel_launch: workspace %zu < %zu or n_in %d != 28\n", ws_size, (size_t)WS_NEED, n_in); grid_blocks = -1; }
    }
    if (grid_blocks < 0) return;
    if (hipMemsetAsync((char*)d_ws + OFF_BAR, 0, 16384, stream) != hipSuccess) { fprintf(stderr, "kernel_launch: memset failed\n"); return; }
    Params p{};
    for (int i = 0; i < 28; ++i) p.in[i] = (const float*)d_in[i];
    p.out = (float*)d_out; p.ws = (unsigned char*)d_ws; p.rep = REP_MASK; p.pad = 0;
    void* args[] = {&p};
    hipError_t e = hipLaunchCooperativeKernel((void*)mega, dim3(grid_blocks), dim3(512), args, kLds, stream);
    if (e != hipSuccess) fprintf(stderr, "cooperative launch failed: %s (grid %d)\n", hipGetErrorString(e), grid_blocks);
}
```

```cpp
#include <hip/hip_runtime.h>
#include <hip/hip_cooperative_groups.h>
#include <cstdio>
namespace cg = cooperative_groups;

#define LAS __attribute__((address_space(3)))
typedef unsigned short bf16_t;
typedef short bf16x8 __attribute__((ext_vector_type(8)));
typedef float f32x4 __attribute__((ext_vector_type(4)));
typedef float f32x2 __attribute__((ext_vector_type(2)));
typedef unsigned u32x4 __attribute__((ext_vector_type(4)));
typedef unsigned u32x2 __attribute__((ext_vector_type(2)));

constexpr int D = 2048, T = 8208, SEQ = 8192, W = 512, MP = 16640, MX = 16384, NMIX = 7168, NGATE = 8192, DFF = 5632, NCHK = 65;
constexpr int GRN = 18576, GROFF = 10240, UBLK = 136, UBT = 95 * 136, TF = 8320, FOFF = 112;
constexpr float EPS = 1e-6f;

constexpr size_t OFF_H = 0;
constexpr size_t OFF_NB = OFF_H + (size_t)MP * D * 4;
constexpr size_t OFF_Z = OFF_NB + (size_t)MP * D * 2;
constexpr size_t OFF_WIN = OFF_Z + (size_t)MP * D * 2;
constexpr size_t OFF_WBO = OFF_WIN + (size_t)15360 * 2048 * 2;
constexpr size_t OFF_WOUT = OFF_WBO + (size_t)4 * 2048 * 512 * 2;
constexpr size_t OFF_WGU = OFF_WOUT + (size_t)2048 * 2048 * 2;
constexpr size_t OFF_WD = OFF_WGU + (size_t)11264 * 2048 * 2;
constexpr size_t OFF_ROPE = OFF_WD + (size_t)2048 * 5632 * 2;
constexpr size_t OFF_R = OFF_ROPE + (size_t)T * 64 * 8;
constexpr size_t R_PMIX = OFF_R;
constexpr size_t R_O = R_PMIX + (size_t)MP * NMIX * 2;
constexpr size_t R_LA = R_O + (size_t)4 * MP * W * 2;
constexpr size_t R_BB = R_LA + (size_t)2 * MP * W * 2;
constexpr size_t R_U = R_BB + (size_t)2 * MP * W * 2;
constexpr size_t R_GG = R_U + (size_t)520 * 65536 * 4;
constexpr size_t R_UT = R_GG + (size_t)520 * 512 * 4;
constexpr size_t R_GR = R_UT + (size_t)512 * 2 * TF * 2;
constexpr size_t R_CA = R_GR + (size_t)512 * GRN * 2;
constexpr size_t R_CB = R_CA + (size_t)4 * 65 * 512 * 4;
constexpr size_t R_CR = R_CB + (size_t)4 * 65 * 512 * 4;
constexpr size_t R_YT = R_CR + (size_t)4 * 65 * 512 * 4;
constexpr size_t R_END1 = R_YT + (size_t)512 * 2 * TF * 2;
constexpr size_t R_G = R_LA;
constexpr size_t R_MB = OFF_R;
constexpr size_t R_FF = OFF_R + (size_t)MP * D * 2;
constexpr size_t WS_NEED = (R_G + (size_t)MP * NGATE * 2) > R_END1 ? (R_G + (size_t)MP * NGATE * 2) : R_END1;
static_assert(R_END1 <= WS_NEED, "scratch");
constexpr size_t OFF_BAR = (WS_NEED + 255) & ~(size_t)255;
constexpr size_t OFF_LRUW = OFF_BAR + 16384;
constexpr size_t OFF_LBT = OFF_LRUW + 262144;
constexpr size_t WS_TOTAL = OFF_LBT + 2048;
static_assert(WS_TOTAL <= (size_t)1006632960, "workspace too large");
static_assert(R_FF + (size_t)MP * DFF * 2 <= WS_NEED, "ff");

struct Params { const float* in[28]; float* out; unsigned char* ws; int rep; int pad; };
typedef const __attribute__((address_space(4))) Params CParams;

__device__ __forceinline__ float bf2f(bf16_t b) { return __uint_as_float(((unsigned)b) << 16); }
typedef __bf16 bf16v2 __attribute__((ext_vector_type(2)));
__device__ __forceinline__ unsigned pk2(float lo, float hi) { const f32x2 v = {lo, hi}; const bf16v2 b = __builtin_convertvector(v, bf16v2); return __builtin_bit_cast(unsigned, b); }
__device__ __forceinline__ unsigned f2bf(float f) { return pk2(f, 0.f) & 0xffffu; }
__device__ __forceinline__ float sigm(float x) { return __builtin_amdgcn_rcpf(1.0f + __expf(-x)); }
__device__ __forceinline__ float siluf(float x) { return x * sigm(x); }
__device__ __forceinline__ float gelu_tanh(float x) { return 0.5f * x * (1.0f + tanhf(0.7978845608028654f * (x + 0.044715f * x * x * x))); }
__device__ __forceinline__ int row_of(int b, int t) { return t < 16 ? (MX + b * 128 + 112 + t) : (b * SEQ + (t - 16)); }
__device__ __forceinline__ int row_bci(int b, int c, int i) { return c == 0 ? (MX + b * 128 + i) : (b * SEQ + (c - 1) * 128 + i); }
__device__ __forceinline__ int opaque_tid() { int t = threadIdx.x; asm volatile("" : "+v"(t)); return t; }
#define LDS_WAIT() asm volatile("s_waitcnt lgkmcnt(0)" ::: "memory")

namespace pg8 {
constexpr int BM = 256, BK = 64, HALF = 128, HTB = HALF * BK * 2, NXCD = 8, WGM = 8;
__device__ __forceinline__ int lds_byte(int r, int c) { const int st = (r >> 4) * 2 + (c >> 5), rr = r & 15, cc = c & 31, ob = rr * 64 + cc * 2; return st * 1024 + (ob ^ (((ob >> 9) & 1) << 5)); }
__device__ __forceinline__ void stage_rc(int b, int& R, int& C) { const int st = b / 1024, sb = b % 1024, swz = sb ^ (((sb >> 9) & 1) << 5); R = (st >> 1) * 16 + swz / 64; C = (st & 1) * 32 + (swz % 64) / 2; }
__device__ __forceinline__ int perm32(int rho) { const int n = rho >> 4, i = rho & 15; return 8 * (i >> 2) + 4 * n + (i & 3); }
struct Unit { int pm, pn, z; };
__device__ __forceinline__ bool tile_of(long L, int nM, int nN, int WGMr, int& pm, int& pn) {
    const int nwg = nM * nN; if (L >= nwg) return false;
    int wgid = (int)L; { const int q = nwg / NXCD, r = nwg % NXCD, xcd = wgid % NXCD, off = wgid / NXCD; wgid = (xcd < r ? xcd * (q + 1) : r * (q + 1) + (xcd - r) * q) + off; }
    const int nig = WGMr * nN, gid = wgid / nig, fm = gid * WGMr, gsz = (nM - fm) < WGMr ? (nM - fm) : WGMr;
    pm = fm + ((wgid % nig) % gsz); pn = (wgid % nig) / gsz; return true;
}
struct PlainSched {
    int nM, nN, G, c; const char* A; const char* B; size_t at, bt; int wgm;
    __device__ __forceinline__ bool next(int i, Unit& u) const { u.z = 0; return tile_of((long)i * G + c, nM, nN, wgm, u.pm, u.pn); }
    __device__ __forceinline__ const char* aptr(const Unit& u) const { return A + (size_t)u.pm * at; }
    __device__ __forceinline__ const char* bptr(const Unit& u) const { return B + (size_t)u.pn * bt; }
};
struct BranchSched {
    int nM, nN, G, c; const char* A; const char* B; size_t at, bt; int wgm;
    __device__ __forceinline__ bool next(int i, Unit& u) const { u.z = i & 3; return tile_of((long)(i >> 2) * G + c, nM, nN, wgm, u.pm, u.pn); }
    __device__ __forceinline__ const char* aptr(const Unit& u) const { return A + (size_t)u.pm * at + (size_t)u.z * (W * 2); }
    __device__ __forceinline__ const char* bptr(const Unit& u) const { return B + (size_t)u.z * ((size_t)D * W * 2) + (size_t)u.pn * bt; }
};

template <int ACT> struct EpiBf16 {
    static constexpr bool PERM = true;
    bf16_t* O; int ldc;
    __device__ __forceinline__ void operator()(const f32x4 (&acc)[2][2][4][2], const Unit& u, int wr, int wc, int fr, int fq) const {
        const int row0 = u.pm * BM + wr * 64 + fr, col0 = u.pn * BM + wc * 32 + 8 * fq;
#pragma unroll
        for (int ai = 0; ai < 2; ++ai)
#pragma unroll
            for (int m = 0; m < 4; ++m) { bf16_t* rowp = O + (size_t)(row0 + ai * HALF + m * 16) * ldc + col0;
#pragma unroll
                for (int bj = 0; bj < 2; ++bj) { f32x4 v0 = acc[ai][bj][m][0], v1 = acc[ai][bj][m][1];
                    if (ACT == 1) {
#pragma unroll
                        for (int j = 0; j < 4; ++j) { v0[j] = sigm(v0[j]); v1[j] = sigm(v1[j]); } }
                    u32x4 w; w.x = pk2(v0[0], v0[1]); w.y = pk2(v0[2], v0[3]); w.z = pk2(v1[0], v1[1]); w.w = pk2(v1[2], v1[3]);
                    *(u32x4*)(rowp + bj * HALF) = w; } }
    }
};
struct EpiBranch {
    static constexpr bool PERM = true;
    bf16_t* MB; const bf16_t* G;
    __device__ __forceinline__ void operator()(const f32x4 (&acc)[2][2][4][2], const Unit& u, int wr, int wc, int fr, int fq) const {
        const int row0 = u.pm * BM + wr * 64 + fr, col0 = u.pn * BM + wc * 32 + 8 * fq;
#pragma unroll
        for (int ai = 0; ai < 2; ++ai)
#pragma unroll
          for (int mp = 0; mp < 2; ++mp) {
            u32x4 g[2][2], pv[2][2];
#pragma unroll
            for (int mm = 0; mm < 2; ++mm)
#pragma unroll
                for (int bj = 0; bj < 2; ++bj) { const size_t r = (size_t)(row0 + ai * HALF + (2 * mp + mm) * 16);
                    g[mm][bj] = *(const u32x4*)(G + r * NGATE + u.z * D + col0 + bj * HALF);
                    pv[mm][bj] = (u32x4){0u, 0u, 0u, 0u}; if (u.z) pv[mm][bj] = *(const u32x4*)(MB + r * D + col0 + bj * HALF); }
#pragma unroll
            for (int mm = 0; mm < 2; ++mm)
#pragma unroll
                for (int bj = 0; bj < 2; ++bj) { const int m = 2 * mp + mm; const size_t r = (size_t)(row0 + ai * HALF + m * 16);
                    const f32x4 v0 = acc[ai][bj][m][0], v1 = acc[ai][bj][m][1];
                    float o[8];
                    o[0] = v0[0]; o[1] = v0[1]; o[2] = v0[2]; o[3] = v0[3]; o[4] = v1[0]; o[5] = v1[1]; o[6] = v1[2]; o[7] = v1[3];
                    u32x4 w;
#pragma unroll
                    for (int q = 0; q < 4; ++q) {
                        const float g0 = sigm(__uint_as_float(g[mm][bj][q] << 16)), g1 = sigm(__uint_as_float(g[mm][bj][q] & 0xffff0000u));
                        const float p0 = __uint_as_float(pv[mm][bj][q] << 16), p1 = __uint_as_float(pv[mm][bj][q] & 0xffff0000u);
                        w[q] = pk2(p0 + g0 * o[2 * q], p1 + g1 * o[2 * q + 1]); }
                    *(u32x4*)(MB + r * D + col0 + bj * HALF) = w; } }
    }
};
struct EpiResid {
    static constexpr bool PERM = false;
    float* H; const float* S;
    __device__ __forceinline__ void operator()(const f32x4 (&acc)[2][2][4][2], const Unit& u, int wr, int wc, int fr, int fq) const {
        const int row0 = u.pm * BM + wr * 64 + fr, col0 = u.pn * BM + wc * 32 + 4 * fq;
#pragma unroll
        for (int ai = 0; ai < 2; ++ai)
#pragma unroll
            for (int mp = 0; mp < 2; ++mp) {
                f32x4 old[2][2][2];
#pragma unroll
                for (int mm = 0; mm < 2; ++mm)
#pragma unroll
                    for (int bj = 0; bj < 2; ++bj)
#pragma unroll
                        for (int n = 0; n < 2; ++n) old[mm][bj][n] = *(const f32x4*)(S + (size_t)(row0 + ai * HALF + (2 * mp + mm) * 16) * D + col0 + bj * HALF + n * 16);
#pragma unroll
                for (int mm = 0; mm < 2; ++mm)
#pragma unroll
                    for (int bj = 0; bj < 2; ++bj)
#pragma unroll
                        for (int n = 0; n < 2; ++n) *(f32x4*)(H + (size_t)(row0 + ai * HALF + (2 * mp + mm) * 16) * D + col0 + bj * HALF + n * 16) = old[mm][bj][n] + acc[ai][bj][2 * mp + mm][n]; }
    }
};
struct EpiSwiglu {
    static constexpr bool PERM = true;
    bf16_t* FF;
    __device__ __forceinline__ void operator()(const f32x4 (&acc)[2][2][4][2], const Unit& u, int wr, int wc, int fr, int fq) const {
        const int row0 = u.pm * BM + wr * 64 + fr, col0 = u.pn * HALF + wc * 32 + 8 * fq;
#pragma unroll
        for (int ai = 0; ai < 2; ++ai)
#pragma unroll
            for (int m = 0; m < 4; ++m) { bf16_t* rowp = FF + (size_t)(row0 + ai * HALF + m * 16) * DFF + col0;
                const f32x4 g0 = acc[ai][0][m][0], g1 = acc[ai][0][m][1], u0 = acc[ai][1][m][0], u1 = acc[ai][1][m][1];
                u32x4 w; w.x = pk2(siluf(g0[0]) * u0[0], siluf(g0[1]) * u0[1]); w.y = pk2(siluf(g0[2]) * u0[2], siluf(g0[3]) * u0[3]);
                w.z = pk2(siluf(g1[0]) * u1[0], siluf(g1[1]) * u1[1]); w.w = pk2(siluf(g1[2]) * u1[2], siluf(g1[3]) * u1[3]);
                *(u32x4*)rowp = w; }
    }
};

template <class Epi, class Sched>
__device__ __forceinline__ void gemm_phase(LAS unsigned char* lds, const int lda, const int ldb, const int K, const Sched& S, const Epi& E) {
    const int tid = opaque_tid(), wid = __builtin_amdgcn_readfirstlane(tid >> 6), lane = tid & 63, wr = wid >> 2, wc = wid & 3, fr = lane & 15, fq = lane >> 4;
    const int nt = K / BK;
    unsigned voffA[2], voffB[2];
#pragma unroll
    for (int i = 0; i < 2; ++i) { int R, C; stage_rc(tid * 16 + i * 8192, R, C); const int Rb = Epi::PERM ? ((R & ~31) + perm32(R & 31)) : R;
        voffA[i] = (unsigned)(R * lda + C) * 2u; voffB[i] = (unsigned)(Rb * ldb + C) * 2u; }
    const size_t kstep = (size_t)(BK * 2);
    const size_t hstepA = (size_t)HALF * lda * 2, hstepB = (size_t)HALF * ldb * 2;
    const unsigned ldsw = (unsigned)wid * 1024u;
    const int aoff = lds_byte(wr * 64 + fr, fq * 8), boff = lds_byte(wc * 32 + fr, fq * 8);
#define PG8_SA(b, h) (((b) * 2 + (h)) * HTB)
#define PG8_SB(b, h) ((4 + (b) * 2 + (h)) * HTB)
#define PG8_STAGE(bufoff, gbase, voff) do { _Pragma("unroll") for (int _i = 0; _i < 2; ++_i) \
        __builtin_amdgcn_global_load_lds((const unsigned*)((const char*)(gbase) + (voff)[_i]), (LAS unsigned*)(lds + (bufoff) + ldsw + _i * 8192), 16, 0, 0); } while (0)
#define PG8_LDA(dst, b, h) do { _Pragma("unroll") for (int m = 0; m < 4; ++m) _Pragma("unroll") for (int k = 0; k < 2; ++k) dst[m][k] = *(const LAS bf16x8*)(lds + PG8_SA(b, h) + aoff + m * 2048 + k * 1024); } while (0)
#define PG8_LDB(dst, b, h) do { _Pragma("unroll") for (int n = 0; n < 2; ++n) _Pragma("unroll") for (int k = 0; k < 2; ++k) dst[n][k] = *(const LAS bf16x8*)(lds + PG8_SB(b, h) + boff + n * 2048 + k * 1024); } while (0)
#define PG8_MMA(ai, bj, At, Bt) do { __builtin_amdgcn_s_setprio(1); _Pragma("unroll") for (int m = 0; m < 4; ++m) _Pragma("unroll") for (int n = 0; n < 2; ++n) _Pragma("unroll") for (int k = 0; k < 2; ++k) \
        acc[ai][bj][m][n] = __builtin_amdgcn_mfma_f32_16x16x32_bf16(Bt[n][k], At[m][k], acc[ai][bj][m][n], 0, 0, 0); __builtin_amdgcn_s_setprio(0); } while (0)
#define PG8_WAIT_V(n) asm volatile("s_waitcnt vmcnt(" #n ")" ::: "memory")
#define PG8_WAIT_L(n) asm volatile("s_waitcnt lgkmcnt(" #n ")" ::: "memory")
#define PG8_BAR __builtin_amdgcn_s_barrier()
#define PG8_SCHED __builtin_amdgcn_sched_barrier(0)
    Unit cur, nxt; int ui = 0;
    if (!S.next(0, cur)) return;
    f32x4 acc[2][2][4][2];
#pragma unroll
    for (int a = 0; a < 2; ++a)
#pragma unroll
        for (int b = 0; b < 2; ++b)
#pragma unroll
            for (int m = 0; m < 4; ++m)
#pragma unroll
                for (int n = 0; n < 2; ++n) acc[a][b][m][n] = (f32x4){0.f, 0.f, 0.f, 0.f};
    bf16x8 At[4][2], B0[2][2], B1[2][2];
    const char* cA = S.aptr(cur); const char* cB = S.bptr(cur);
    PG8_STAGE(PG8_SB(0, 0), cB, voffB); PG8_STAGE(PG8_SA(0, 0), cA, voffA); PG8_STAGE(PG8_SB(0, 1), cB + hstepB, voffB); PG8_STAGE(PG8_SA(0, 1), cA + hstepA, voffA);
    if (wr == 1) PG8_BAR;
    PG8_WAIT_V(4); PG8_BAR;
    PG8_STAGE(PG8_SB(1, 0), cB + kstep, voffB); PG8_STAGE(PG8_SA(1, 0), cA + kstep, voffA); PG8_STAGE(PG8_SB(1, 1), cB + hstepB + kstep, voffB);
    PG8_WAIT_V(6); PG8_BAR;
    for (;;) {
        const bool has_next = S.next(ui + 1, nxt);
        const char* nA = has_next ? S.aptr(nxt) : cA; const char* nB = has_next ? S.bptr(nxt) : cB;
        for (int t = 0; t < nt; t += 2) {
            const bool last = (t == nt - 2);
            const char* a1 = cA + (size_t)(t + 1) * kstep;
            const char* a2 = last ? nA : cA + (size_t)(t + 2) * kstep; const char* b2 = last ? nB : cB + (size_t)(t + 2) * kstep;
            const char* a3 = a2 + kstep; const char* b3 = b2 + kstep;
            PG8_LDB(B0, 0, 0); PG8_SCHED; PG8_LDA(At, 0, 0); PG8_STAGE(PG8_SA(1, 1), a1 + hstepA, voffA);
            PG8_WAIT_L(8); PG8_BAR; PG8_WAIT_L(0); PG8_MMA(0, 0, At, B0); PG8_BAR; PG8_SCHED;
            PG8_LDB(B1, 0, 1); PG8_STAGE(PG8_SB(0, 0), b2, voffB);
            PG8_BAR; PG8_WAIT_L(0); PG8_MMA(0, 1, At, B1); PG8_BAR;
            PG8_LDA(At, 0, 1); PG8_STAGE(PG8_SA(0, 0), a2, voffA);
            PG8_BAR; PG8_WAIT_L(0); PG8_MMA(1, 0, At, B0); PG8_BAR; PG8_SCHED;
            PG8_STAGE(PG8_SB(0, 1), b2 + hstepB, voffB);
            PG8_WAIT_V(6); PG8_BAR; PG8_MMA(1, 1, At, B1); PG8_BAR;
            PG8_LDB(B0, 1, 0); PG8_SCHED; PG8_LDA(At, 1, 0); PG8_STAGE(PG8_SA(0, 1), a2 + hstepA, voffA);
            PG8_WAIT_L(8); PG8_BAR; PG8_WAIT_L(0); PG8_MMA(0, 0, At, B0); PG8_BAR; PG8_SCHED;
            PG8_LDB(B1, 1, 1); PG8_STAGE(PG8_SB(1, 0), b3, voffB);
            PG8_BAR; PG8_WAIT_L(0); PG8_MMA(0, 1, At, B1); PG8_BAR;
            PG8_LDA(At, 1, 1); PG8_STAGE(PG8_SA(1, 0), a3, voffA);
            PG8_BAR; PG8_WAIT_L(0); PG8_MMA(1, 0, At, B0); PG8_BAR; PG8_SCHED;
            PG8_STAGE(PG8_SB(1, 1), b3 + hstepB, voffB);
            PG8_WAIT_V(6); PG8_BAR; PG8_MMA(1, 1, At, B1); PG8_BAR;
        }
        E(acc, cur, wr, wc, fr, fq);
        if (!has_next) break;
#pragma unroll
        for (int a = 0; a < 2; ++a)
#pragma unroll
            for (int b = 0; b < 2; ++b)
#pragma unroll
                for (int m = 0; m < 4; ++m)
#pragma unroll
                    for (int n = 0; n < 2; ++n) acc[a][b][m][n] = (f32x4){0.f, 0.f, 0.f, 0.f};
        cur = nxt; cA = nA; cB = nB; ++ui;
    }
    PG8_WAIT_V(0);
    if (wr == 0) PG8_BAR;
    PG8_BAR;
#undef PG8_SA
#undef PG8_SB
#undef PG8_STAGE
#undef PG8_LDA
#undef PG8_LDB
#undef PG8_MMA
#undef PG8_WAIT_V
#undef PG8_WAIT_L
#undef PG8_BAR
#undef PG8_SCHED
}
}

struct XpItem { const float* src; bf16_t* dst; int K, N, k0, n0, row0; };
__device__ __forceinline__ void xpose_load(const XpItem& x, int lane, f32x4 (&v)[8]) {
#pragma unroll
    for (int i = 0; i < 8; ++i) v[i] = *(const f32x4*)(x.src + (size_t)(x.k0 + 8 * i + (lane >> 3)) * x.N + x.n0 + (lane & 7) * 4);
}
__device__ __forceinline__ void xpose_finish(const XpItem& x, int lane, const f32x4 (&v)[8], LAS float* scr) {
#pragma unroll
    for (int i = 0; i < 8; ++i) { LAS float* d = scr + (8 * i + (lane >> 3)) * 33 + (lane & 7) * 4; d[0] = v[i][0]; d[1] = v[i][1]; d[2] = v[i][2]; d[3] = v[i][3]; }
    LDS_WAIT(); asm volatile("" ::: "memory");
    const int c = lane & 7;
#pragma unroll
    for (int j = 0; j < 4; ++j) { const int n = (lane >> 3) + 8 * j; const LAS float* s = scr + (8 * c) * 33 + n;
        u32x4 o; o.x = pk2(s[0 * 33], s[1 * 33]); o.y = pk2(s[2 * 33], s[3 * 33]); o.z = pk2(s[4 * 33], s[5 * 33]); o.w = pk2(s[6 * 33], s[7 * 33]);
        *(u32x4*)(x.dst + (size_t)(x.row0 + n) * x.K + x.k0 + 8 * c) = o; }
    LDS_WAIT(); asm volatile("" ::: "memory");
}

__device__ __forceinline__ float wave_sum(float v) {
#pragma unroll
    for (int o = 1; o < 64; o <<= 1) v += __shfl_xor(v, o);
    return v;
}

__device__ __forceinline__ void norm_rows(CParams& p, int mode, const float* gain, int nrows) {
    float* H = (float*)(p.ws + OFF_H); bf16_t* NB = (bf16_t*)(p.ws + OFF_NB);
    const int tid0 = opaque_tid(); const int lane = tid0 & 63, gw = blockIdx.x * 8 + (tid0 >> 6), NW = gridDim.x * 8;
    for (int row = gw; row < nrows; row += NW) {
        f32x4 v[8];
        if (mode == 0) {
            const float* src = nullptr;
            if (row < MX) src = p.in[0] + (size_t)row * D;
            else { const int i = (row - MX) & 127; if (i >= 112) src = p.in[1] + (size_t)(i - 112) * D; }
#pragma unroll
            for (int j = 0; j < 8; ++j) { v[j] = src ? *(const f32x4*)(src + (lane + 64 * j) * 4) : (f32x4){0.f, 0.f, 0.f, 0.f}; if (row >= MX) *(f32x4*)(H + (size_t)row * D + (lane + 64 * j) * 4) = v[j]; }
        } else {
#pragma unroll
            for (int j = 0; j < 8; ++j) v[j] = *(const f32x4*)(H + (size_t)row * D + (lane + 64 * j) * 4);
        }
        float s = 0.f;
#pragma unroll
        for (int j = 0; j < 8; ++j) s += (v[j][0] * v[j][0] + v[j][1] * v[j][1]) + (v[j][2] * v[j][2] + v[j][3] * v[j][3]);
        const float rs = 1.0f / sqrtf(wave_sum(s) * (1.0f / D) + EPS);
#pragma unroll
        for (int j = 0; j < 8; ++j) {
            const f32x4 g = *(const f32x4*)(gain + (lane + 64 * j) * 4);
            const f32x4 y = v[j] * rs * g;
            if (mode == 3) *(f32x4*)(p.out + (size_t)row * D + (lane + 64 * j) * 4) = y;
            else { u32x2 w; w.x = pk2(y[0], y[1]); w.y = pk2(y[2], y[3]); *(u32x2*)(NB + (size_t)row * D + (lane + 64 * j) * 4) = w; }
        }
    }
}

constexpr int FPOS = 36;
__device__ __forceinline__ void filter_item(CParams& p, int layer, int it, LAS float* l) {
    LAS float* Zf = l; LAS float* H1 = l + FPOS * 33; LAS float* H2T = H1 + FPOS * 64;
    LAS float* W1L = H2T + 64 * FPOS; LAS float* W2L = W1L + 33 * 64;
    const int tid = opaque_tid(), n0 = it * FPOS;
    const float* w1 = p.in[14] + layer * 33 * 64; const float* b1 = p.in[15] + layer * 64; const float* w2 = p.in[16] + layer * 64 * 64;
    const float* b2 = p.in[17] + layer * 64; const float* w3 = p.in[18] + layer * 64 * 1024; const float* decay = p.in[19] + layer * 1024;
    bf16_t* GR = (bf16_t*)(p.ws + R_GR);
    __syncthreads();
    {
        const f32x4 t0 = *(const f32x4*)(w1 + 4 * tid), t2 = *(const f32x4*)(w2 + 4 * tid), t3 = *(const f32x4*)(w2 + 2048 + 4 * tid);
        f32x4 t1 = (f32x4){0.f, 0.f, 0.f, 0.f}; if (tid < 16) t1 = *(const f32x4*)(w1 + 2048 + 4 * tid);
        *(LAS f32x4*)(W1L + 4 * tid) = t0; if (tid < 16) *(LAS f32x4*)(W1L + 2048 + 4 * tid) = t1;
        *(LAS f32x4*)(W2L + 4 * tid) = t2; *(LAS f32x4*)(W2L + 2048 + 4 * tid) = t3; }
    for (int idx = tid; idx < FPOS * 33; idx += 512) { const int pos = idx / 33, e = idx % 33, n = n0 + pos; float v;
        if (e == 0) v = (float)n / 8207.0f;
        else { const int k = (e - 1) & 15; const float fr = 1e-4f + (float)k * ((15.0f - 1e-4f) / 15.0f); const double rev = (double)n * (double)fr * (1.0 / 8208.0); const float fx = (float)(rev - floor(rev));
               v = (e <= 16) ? __builtin_amdgcn_cosf(fx) : -__builtin_amdgcn_sinf(fx); }
        Zf[pos * 33 + e] = v; }
    __syncthreads();
    for (int pos = tid >> 4; pos < FPOS; pos += 32) { const int k4 = (tid & 15) * 4; float a[4];
#pragma unroll
      for (int q = 0; q < 4; ++q) a[q] = b1[k4 + q];
#pragma unroll 3
      for (int e = 0; e < 33; ++e) { const float z = Zf[pos * 33 + e];
#pragma unroll
          for (int q = 0; q < 4; ++q) a[q] += z * W1L[e * 64 + k4 + q]; }
#pragma unroll
      for (int q = 0; q < 4; ++q) H1[pos * 64 + k4 + q] = __builtin_amdgcn_sinf(a[q] * 0.15915494309189535f); }
    __syncthreads();
    for (int pos = tid >> 4; pos < FPOS; pos += 32) { const int k4 = (tid & 15) * 4; float a[4];
#pragma unroll
      for (int q = 0; q < 4; ++q) a[q] = b2[k4 + q];
#pragma unroll 4
      for (int j = 0; j < 64; ++j) { const float z = H1[pos * 64 + j];
#pragma unroll
          for (int q = 0; q < 4; ++q) a[q] += z * W2L[j * 64 + k4 + q]; }
#pragma unroll
      for (int q = 0; q < 4; ++q) H2T[(k4 + q) * FPOS + pos] = __builtin_amdgcn_sinf(a[q] * 0.15915494309189535f); }
    __syncthreads();
    { float acc0[FPOS], acc1[FPOS];
#pragma unroll
      for (int q = 0; q < FPOS; ++q) { acc0[q] = 0.f; acc1[q] = 0.f; }
#pragma unroll 1
      for (int k8 = 0; k8 < 64; k8 += 8) { float wa8[8], wb8[8];
#pragma unroll
        for (int kk = 0; kk < 8; ++kk) { wa8[kk] = w3[(k8 + kk) * 1024 + tid]; wb8[kk] = w3[(k8 + kk) * 1024 + 512 + tid]; }
#pragma unroll
        for (int kk = 0; kk < 8; ++kk) { const int k = k8 + kk; const float wa = wa8[kk], wb = wb8[kk];
#pragma unroll
          for (int p4 = 0; p4 < FPOS / 4; ++p4) { const f32x4 h = *(const LAS f32x4*)(H2T + k * FPOS + p4 * 4);
#pragma unroll
              for (int q = 0; q < 4; ++q) { acc0[4 * p4 + q] += h[q] * wa; acc1[4 * p4 + q] += h[q] * wb; } } } }
      const float da = fabsf(decay[tid]), db = fabsf(decay[512 + tid]);
      static_assert(T % FPOS == 0 && FPOS % 4 == 0 && (GROFF % 4) == 0, "filter store grouping");
      bf16_t* gf = GR + (size_t)tid * GRN + (GROFF - n0);
      bf16_t* gb = GR + (size_t)tid * GRN + (GROFF + n0);
      const float sa = -da / 8207.0f, sb = -db / 8207.0f;
#define FE0(q) (acc0[q] * __expf(sa * (float)(n0 + (q))))
#define FE1(q) (acc1[q] * __expf(sb * (float)(n0 + (q))))
      gf[0] = (bf16_t)f2bf(FE0(0));
#pragma unroll
      for (int k = 1; k <= 8; ++k) { u32x2 w; w.x = pk2(FE0(4 * k), FE0(4 * k - 1)); w.y = pk2(FE0(4 * k - 2), FE0(4 * k - 3)); *(u32x2*)(gf - 4 * k) = w; }
      *(unsigned*)(gf - 34) = pk2(FE0(34), FE0(33));
      gf[-35] = (bf16_t)f2bf(FE0(35));
      if (it == 0) { gb[1] = (bf16_t)f2bf(FE1(1)); gb[2] = (bf16_t)f2bf(FE1(2)); gb[3] = (bf16_t)f2bf(FE1(3)); }
      else { u32x2 w; w.x = pk2(FE1(0), FE1(1)); w.y = pk2(FE1(2), FE1(3)); *(u32x2*)gb = w; }
#pragma unroll
      for (int k = 1; k < 9; ++k) { u32x2 w; w.x = pk2(FE1(4 * k), FE1(4 * k + 1)); w.y = pk2(FE1(4 * k + 2), FE1(4 * k + 3)); *(u32x2*)(gb + 4 * k) = w; }
#undef FE0
#undef FE1
    }
}

__device__ __forceinline__ void phase_prep(CParams& p, int layer, LAS unsigned char* lds) {
    const int tid = opaque_tid(), lane = tid & 63, wave = tid >> 6;
    for (int it = blockIdx.x; it < (T + FPOS - 1) / FPOS; it += gridDim.x) filter_item(p, layer, it, (LAS float*)lds);
    __syncthreads();
    if (layer == 0) {
        f32x2* RT = (f32x2*)(p.ws + OFF_ROPE);
        for (int idx = blockIdx.x * 512 + tid; idx < T * 64; idx += gridDim.x * 512) { const int pos = idx >> 6, j = idx & 63;
            double inv = 1.0; for (int q = 0; q < j; ++q) inv *= 0.8659643233600653; const double rev = (double)pos * inv * 0.15915494309189535; const float fx = (float)(rev - floor(rev));
            RT[idx] = (f32x2){__builtin_amdgcn_cosf(fx), __builtin_amdgcn_sinf(fx)}; }
    }
    if (blockIdx.x == 0) { const float l0 = p.in[21][tid], l1 = p.in[21][W + tid]; ((float*)(p.ws + OFF_LBT))[tid] = (layer == 1) ? 1.0f / (1.0f + expf(l0 - l1)) : 0.f; }
    { bf16_t* Wg = (bf16_t*)(p.ws + OFF_LRUW);
      for (int idx = blockIdx.x * 512 + tid; idx < 131072; idx += gridDim.x * 512) { const int i = idx & 63, jj = (idx >> 6) & 63, kb = (idx >> 12) & 7, m = idx >> 15;
          const float* src = (m & 1) ? p.in[9] : p.in[7]; Wg[idx] = (bf16_t)f2bf(src[(size_t)((layer * 2 + (m >> 1)) * 8 + kb) * 4096 + i * 64 + jj]); } }
    LAS float* scr = (LAS float*)lds + wave * (64 * 33);
    const int gw = blockIdx.x * 8 + wave, NW = gridDim.x * 8;
    constexpr int I_IN = 32 * 480, I_BO = 8 * 64, I_OUT = 32 * 64, I_G = 32 * 176, I_D = 88 * 64;
    constexpr int NIT = I_IN + 4 * I_BO + I_OUT + 2 * I_G + I_D;
    auto decode = [&](int it, XpItem& x) {
        int r = it;
        if (r < I_IN) { const int nb = r % 480, kb = r / 480; x = XpItem{p.in[4] + (size_t)layer * D * 15360, (bf16_t*)(p.ws + OFF_WIN), D, 15360, kb * 64, nb * 32, nb * 32}; return; } r -= I_IN;
        if (r < 4 * I_BO) { const int z = r / I_BO, q = r % I_BO, nb = q % 64, kb = q / 64;
            x = XpItem{p.in[22] + ((size_t)layer * 4 + z) * W * D, (bf16_t*)(p.ws + OFF_WBO) + (size_t)z * D * W, W, D, kb * 64, nb * 32, nb * 32}; return; } r -= 4 * I_BO;
        if (r < I_OUT) { const int nb = r % 64, kb = r / 64; x = XpItem{p.in[23] + (size_t)layer * D * D, (bf16_t*)(p.ws + OFF_WOUT), D, D, kb * 64, nb * 32, nb * 32}; return; } r -= I_OUT;
        if (r < 2 * I_G) { const int up = r / I_G, q = r % I_G, nb = q % 176, kb = q / 176, n0 = nb * 32;
            x = XpItem{p.in[up ? 25 : 24] + (size_t)layer * D * DFF, (bf16_t*)(p.ws + OFF_WGU), D, DFF, kb * 64, n0, 256 * (n0 >> 7) + (n0 & 127) + up * 128}; return; } r -= 2 * I_G;
        { const int nb = r % 64, kb = r / 64; x = XpItem{p.in[26] + (size_t)layer * DFF * D, (bf16_t*)(p.ws + OFF_WD), DFF, D, kb * 64, nb * 32, nb * 32}; }
    };
    {
        XpItem cur, nxt; f32x4 vc[8], vn[8];
        int it = gw;
        if (it < NIT) { decode(it, cur); xpose_load(cur, lane, vc); }
        for (; it < NIT; it += NW) {
            const bool hn = (it + NW) < NIT;
            if (hn) { decode(it + NW, nxt); xpose_load(nxt, lane, vn); }
            xpose_finish(cur, lane, vc, scr);
            if (hn) { cur = nxt;
#pragma unroll
                for (int i = 0; i < 8; ++i) vc[i] = vn[i]; }
        }
    }
    norm_rows(p, layer == 0 ? 0 : 1, p.in[2] + layer * D, MP);
}

__device__ __forceinline__ void lru_s1_item(CParams& p, int layer, int item, LAS unsigned char* lds) {
    const int cidx = item >> 3, kb = item & 7, b = cidx / NCHK, c = cidx % NCHK;
    const int tid = opaque_tid(), lane = tid & 63, wave = tid >> 6;
    constexpr int XS = 72;
    LAS bf16_t* XCb = (LAS bf16_t*)lds;
    LAS bf16_t* WT = XCb + 128 * XS;
    LAS float* XCf = (LAS float*)(lds + (128 + 256) * XS * 2);
    LAS float* AG = XCf + 8192;
    const bf16_t* P = (const bf16_t*)(p.ws + R_PMIX);
    bf16_t* LA = (bf16_t*)(p.ws + R_LA); bf16_t* BB = (bf16_t*)(p.ws + R_BB);
    __syncthreads();
    {
        const bf16_t* Wg = (const bf16_t*)(p.ws + OFF_LRUW);
        for (int q = tid; q < 2048; q += 512) { const int n = q >> 3, part = q & 7, m = n >> 6, jj = n & 63;
            *(LAS u32x4*)(WT + n * XS + part * 8) = *(const u32x4*)(Wg + ((size_t)(m * 8 + kb) * 64 + jj) * 64 + part * 8); } }
    {
        const int j = tid & 63, tq = tid >> 6, ch = kb * 64 + j;
        const float* cw = p.in[5] + layer * 4 * W; const float cb = p.in[6][layer * W + ch];
        const float w0 = cw[ch], w1 = cw[W + ch], w2 = cw[2 * W + ch], w3 = cw[3 * W + ch];
        const int t0 = c * 128 + 16 * tq - 112;
        float xv[19];
#pragma unroll
        for (int q = 0; q < 19; ++q) { const int t = t0 - 2 + q; xv[q] = (t >= 0 && t < T) ? bf2f(P[(size_t)row_of(b, t) * NMIX + ch]) : 0.f; }
#pragma unroll
        for (int tt = 0; tt < 16; ++tt) { const float x = cb + w0 * xv[tt] + w1 * xv[tt + 1] + w2 * xv[tt + 2] + w3 * xv[tt + 3];
            XCf[(16 * tq + tt) * 64 + j] = x; XCb[(16 * tq + tt) * XS + j] = (bf16_t)f2bf(x); } }
    __syncthreads();
    const int r = lane & 15, h = lane >> 4;
    f32x4 acc[16];
#pragma unroll
    for (int nt = 0; nt < 16; ++nt) acc[nt] = (f32x4){0.f, 0.f, 0.f, 0.f};
#pragma unroll
    for (int ks = 0; ks < 2; ++ks) { const bf16x8 a = *(const LAS bf16x8*)(XCb + (16 * wave + r) * XS + 32 * ks + 8 * h);
#pragma unroll
        for (int nt = 0; nt < 16; ++nt) { const bf16x8 bw = *(const LAS bf16x8*)(WT + (16 * nt + r) * XS + 32 * ks + 8 * h);
            acc[nt] = __builtin_amdgcn_mfma_f32_16x16x32_bf16(a, bw, acc[nt], 0, 0, 0); } }
    const int tok0 = 16 * wave + 4 * h, t0 = c * 128 + tok0 - 112;
#pragma unroll
    for (int jt = 0; jt < 4; ++jt) { const int j = 16 * jt + r, ch = kb * 64 + j;
#pragma unroll
        for (int dir = 0; dir < 2; ++dir) {
            const float ba = p.in[8][(layer * 2 + dir) * W + ch], bx = p.in[10][(layer * 2 + dir) * W + ch], lam = p.in[11][(layer * 2 + dir) * W + ch];
            const float sp = log1pf(expf(-lam));
            float Aq = 1.f, Bq = 0.f;
#pragma unroll
            for (int s = 0; s < 4; ++s) { const int q = dir ? 3 - s : s;
                const float rg = sigm(acc[(2 * dir) * 4 + jt][q] + ba), ig = sigm(acc[(2 * dir + 1) * 4 + jt][q] + bx);
                float la = -8.0f * rg * sp; float bv = sqrtf(fmaxf(1.0f - __expf(2.0f * la), 0.f)) * ig * XCf[(tok0 + q) * 64 + j];
                if ((t0 + q) < 0) { la = 0.f; bv = 0.f; }
                const unsigned lab = f2bf(la), bvb = f2bf(bv);
                const size_t ro = (size_t)row_bci(b, c, tok0 + q) * W + ch;
                LA[(size_t)dir * MP * W + ro] = (bf16_t)lab; BB[(size_t)dir * MP * W + ro] = (bf16_t)bvb;
                const float a = __expf(__uint_as_float(lab << 16)), bq = __uint_as_float(bvb << 16);
                Bq = a * Bq + bq; Aq *= a; }
            const int g = 4 * wave + h;
            AG[((g * 2 + dir) * 2 + 0) * 64 + j] = Aq; AG[((g * 2 + dir) * 2 + 1) * 64 + j] = Bq; } }
    __syncthreads();
    if (tid < 128) { const int dir = tid >> 6, jj = tid & 63; float At = 1.f, Bt = 0.f;
        for (int s = 0; s < 32; ++s) { const int q = dir ? 31 - s : s; const float a = AG[((q * 2 + dir) * 2 + 0) * 64 + jj], bq = AG[((q * 2 + dir) * 2 + 1) * 64 + jj]; Bt = a * Bt + bq; At *= a; }
        const size_t o = (size_t)((dir * 2 + b) * NCHK + c) * W + kb * 64 + jj;
        ((float*)(p.ws + R_CA))[o] = At; ((float*)(p.ws + R_CB))[o] = Bt; }
}

__device__ __forceinline__ void lru_carry(CParams& p) {
    const int gt = blockIdx.x * 512 + opaque_tid();
    if (gt < 2048) { const int dir = gt >> 10, b = (gt >> 9) & 1, ch = gt & 511;
        const float* CA = (const float*)(p.ws + R_CA); const float* CB = (const float*)(p.ws + R_CB); float* CR = (float*)(p.ws + R_CR);
        const size_t base = (size_t)((dir * 2 + b) * NCHK) * W + ch; float h = 0.f;
        for (int s0 = 0; s0 < NCHK; s0 += 5) { float a[5], bq[5];
#pragma unroll
            for (int q = 0; q < 5; ++q) { const int c = dir ? NCHK - 1 - (s0 + q) : (s0 + q); a[q] = CA[base + (size_t)c * W]; bq[q] = CB[base + (size_t)c * W]; }
#pragma unroll
            for (int q = 0; q < 5; ++q) { const int c = dir ? NCHK - 1 - (s0 + q) : (s0 + q); CR[base + (size_t)c * W] = h; h = a[q] * h + bq[q]; } } }
}

__device__ __forceinline__ void lru_s3_item(CParams& p, int item, LAS unsigned char* lds) {
    const int cidx = item >> 3, kb = item & 7, b = cidx / NCHK, c = cidx % NCHK;
    const int tid = opaque_tid(), j = tid & 63, tq = tid >> 6, ch = kb * 64 + j;
    LAS float* AG = (LAS float*)lds;
    const bf16_t* P = (const bf16_t*)(p.ws + R_PMIX); const bf16_t* LA = (const bf16_t*)(p.ws + R_LA); const bf16_t* BB = (const bf16_t*)(p.ws + R_BB);
    bf16_t* Z = (bf16_t*)(p.ws + OFF_Z);
    float av[2][16], bv[2][16];
    size_t ro[16];
#pragma unroll
    for (int tt = 0; tt < 16; ++tt) ro[tt] = (size_t)row_bci(b, c, 16 * tq + tt);
#pragma unroll
    for (int dir = 0; dir < 2; ++dir)
#pragma unroll
        for (int tt = 0; tt < 16; ++tt) { const size_t o = (size_t)dir * MP * W + ro[tt] * W + ch; av[dir][tt] = bf2f(LA[o]); bv[dir][tt] = bf2f(BB[o]); }
    __syncthreads();
#pragma unroll
    for (int dir = 0; dir < 2; ++dir) { float Aq = 1.f, Bq = 0.f;
#pragma unroll
        for (int s = 0; s < 16; ++s) { const int tt = dir ? 15 - s : s; const float a = __expf(av[dir][tt]); av[dir][tt] = a; Bq = a * Bq + bv[dir][tt]; Aq *= a; }
        AG[((tq * 2 + dir) * 2 + 0) * 64 + j] = Aq; AG[((tq * 2 + dir) * 2 + 1) * 64 + j] = Bq; }
    __syncthreads();
    float hs[16];
#pragma unroll
    for (int dir = 0; dir < 2; ++dir) {
        float h = ((const float*)(p.ws + R_CR))[(size_t)((dir * 2 + b) * NCHK + c) * W + ch];
        for (int s = 0; s < 7; ++s) { const int q = dir ? 7 - s : s; const bool use = dir ? (q > tq) : (q < tq);
            const float a = AG[((q * 2 + dir) * 2 + 0) * 64 + j], bq = AG[((q * 2 + dir) * 2 + 1) * 64 + j]; if (use) h = a * h + bq; }
#pragma unroll
        for (int s = 0; s < 16; ++s) { const int tt = dir ? 15 - s : s; h = av[dir][tt] * h + bv[dir][tt]; if (dir == 0) hs[tt] = h; else hs[tt] += h; }
    }
#pragma unroll
    for (int tt = 0; tt < 16; ++tt) { const int i = 16 * tq + tt; const bool valid = (c * 128 + i - 112) >= 0;
        const float ga = bf2f(P[ro[tt] * NMIX + 512 + ch]);
        Z[ro[tt] * D + ch] = (bf16_t)(valid ? f2bf(hs[tt] * gelu_tanh(ga)) : 0u); }
}

__device__ __forceinline__ void conv3_16(const bf16_t* P, const float* cw, const float* cbias, int b, int t0, int col, float (&out)[16]) {
    const int cc = col - 1024; const float w0 = cw[cc], w1 = cw[1536 + cc], w2 = cw[3072 + cc], bb = cbias[cc];
    float xv[18];
#pragma unroll
    for (int q = 0; q < 18; ++q) { const int t = t0 - 1 + q; xv[q] = (t >= 0 && t < T) ? bf2f(P[(size_t)row_of(b, t) * NMIX + col]) : 0.f; }
#pragma unroll
    for (int tt = 0; tt < 16; ++tt) out[tt] = bb + w0 * xv[tt] + w1 * xv[tt + 1] + w2 * xv[tt + 2];
}

__device__ __forceinline__ void hy_s1_item(CParams& p, int layer, int item) {
    const int cidx = item >> 3, cgp = item & 7, b = cidx / NCHK, c = cidx % NCHK;
    const int tid = opaque_tid(), j = tid & 63, tq = tid >> 6, ch = cgp * 64 + j;
    const int t0 = c * 128 + 16 * tq - 112;
    if (t0 < 0) return;
    const bf16_t* P = (const bf16_t*)(p.ws + R_PMIX);
    const float* cw = p.in[12] + layer * 3 * 1536; const float* cbias = p.in[13] + layer * 1536;
    float x1[16], vv[16];
    conv3_16(P, cw, cbias, b, t0, 1024 + 512 + ch, x1); conv3_16(P, cw, cbias, b, t0, 1024 + 1024 + ch, vv);
    bf16_t* UT = (bf16_t*)(p.ws + R_UT) + ((size_t)ch * 2 + b) * TF + (t0 + FOFF);
    u32x4 wa, wb;
    wa.x = pk2(x1[0] * vv[0], x1[1] * vv[1]); wa.y = pk2(x1[2] * vv[2], x1[3] * vv[3]); wa.z = pk2(x1[4] * vv[4], x1[5] * vv[5]); wa.w = pk2(x1[6] * vv[6], x1[7] * vv[7]);
    wb.x = pk2(x1[8] * vv[8], x1[9] * vv[9]); wb.y = pk2(x1[10] * vv[10], x1[11] * vv[11]); wb.z = pk2(x1[12] * vv[12], x1[13] * vv[13]); wb.w = pk2(x1[14] * vv[14], x1[15] * vv[15]);
    *(u32x4*)UT = wa; *(u32x4*)(UT + 8) = wb;
}

__device__ __forceinline__ void hy_s3_item(CParams& p, int layer, int item) {
    const int cidx = item >> 3, cgp = item & 7, b = cidx / NCHK, c = cidx % NCHK;
    const int tid = opaque_tid(), j = tid & 63, tq = tid >> 6, ch = cgp * 64 + j;
    const int t0 = c * 128 + 16 * tq - 112;
    bf16_t* Z = (bf16_t*)(p.ws + OFF_Z);
    if (t0 < 0) {
#pragma unroll
        for (int tt = 0; tt < 16; ++tt) Z[(size_t)row_bci(b, c, 16 * tq + tt) * D + 512 + ch] = 0;
        return; }
    const bf16_t* P = (const bf16_t*)(p.ws + R_PMIX);
    const float* cw = p.in[12] + layer * 3 * 1536; const float* cbias = p.in[13] + layer * 1536;
    float x0[16];
    conv3_16(P, cw, cbias, b, t0, 1024 + ch, x0);
    const bf16_t* YT = (const bf16_t*)(p.ws + R_YT) + ((size_t)ch * 2 + b) * TF + (t0 + FOFF);
    const u32x4 ya = *(const u32x4*)YT, yb = *(const u32x4*)(YT + 8);
#pragma unroll
    for (int tt = 0; tt < 16; ++tt) { const unsigned wv = (tt < 8) ? ya[tt >> 1] : yb[(tt - 8) >> 1];
        const float y = (tt & 1) ? __uint_as_float(wv & 0xffff0000u) : __uint_as_float(wv << 16);
        Z[(size_t)row_bci(b, c, 16 * tq + tt) * D + 512 + ch] = (bf16_t)f2bf(x0[tt] * y); }
}

__device__ __forceinline__ bf16x8 toep_frag(const LAS unsigned* G32, int e) {
    const int d = e >> 1; const unsigned sh = (unsigned)(e & 1) * 16u;
    const unsigned w0 = G32[d], w1 = G32[d + 1], w2 = G32[d + 2], w3 = G32[d + 3], w4 = G32[d + 4];
    u32x4 r; r.x = __builtin_amdgcn_alignbit(w1, w0, sh); r.y = __builtin_amdgcn_alignbit(w2, w1, sh); r.z = __builtin_amdgcn_alignbit(w3, w2, sh); r.w = __builtin_amdgcn_alignbit(w4, w3, sh);
    return __builtin_bit_cast(bf16x8, r);
}

__device__ __forceinline__ bf16x8 toep_frag2(const LAS unsigned* q, unsigned sh) {
    const unsigned w0 = q[0], w1 = q[1], w2 = q[2], w3 = q[3], w4 = q[4];
    u32x4 r; r.x = __builtin_amdgcn_alignbit(w1, w0, sh); r.y = __builtin_amdgcn_alignbit(w2, w1, sh); r.z = __builtin_amdgcn_alignbit(w3, w2, sh); r.w = __builtin_amdgcn_alignbit(w4, w3, sh);
    return __builtin_bit_cast(bf16x8, r);
}

__device__ __forceinline__ void hy_conv_item(CParams& p, int layer, int ch, LAS unsigned char* lds) {
    LAS bf16_t* GRl = (LAS bf16_t*)lds; LAS bf16_t* UL = GRl + GRN; LAS float* PART = (LAS float*)(lds + GRN * 2 + 2 * UBT * 2);
    const int tid = opaque_tid(), lane = tid & 63, wave = tid >> 6, r = lane & 15, h = lane >> 4;
    const bf16_t* GRg = (const bf16_t*)(p.ws + R_GR) + (size_t)ch * GRN;
    const bf16_t* UTg = (const bf16_t*)(p.ws + R_UT) + (size_t)ch * 2 * TF;
    bf16_t* YTg = (bf16_t*)(p.ws + R_YT) + (size_t)ch * 2 * TF;
    const float bias = p.in[20][layer * W + ch];
    __syncthreads();
    for (int q = tid; q < GRN / 8; q += 512) { u32x4 v = *(const u32x4*)(GRg + q * 8);
        if (q < 254 || q >= 2306) v = (u32x4){0u, 0u, 0u, 0u}; else if (q == 254) v.x &= 0xffff0000u;
        *(LAS u32x4*)(GRl + q * 8) = v; }
    for (int q = tid; q < 2 * (TF / 8); q += 512) { const int bt = q / (TF / 8), f0 = (q % (TF / 8)) * 8;
        u32x4 v = (u32x4){0u, 0u, 0u, 0u}; if (f0 >= FOFF) v = *(const u32x4*)(UTg + (size_t)bt * TF + f0);
        *(LAS u32x4*)(UL + bt * UBT + ((f0 >> 7) + 15) * UBLK + (f0 & 127)) = v; }
    for (int q = tid; q < 2 * 30 * 17; q += 512) { const int bt = q / 510, rem = q % 510, blk = rem / 17, part = rem % 17; const int bi = blk < 15 ? blk : 65 + blk;
        *(LAS u32x4*)(UL + bt * UBT + bi * UBLK + part * 8) = (u32x4){0u, 0u, 0u, 0u}; }
    __syncthreads();
    const LAS unsigned* G32 = (const LAS unsigned*)GRl;
    { const int bt = wave >> 2, I0 = 1 + 16 * (wave & 3);
      f32x4 acc[8];
#pragma unroll
      for (int mi = 0; mi < 8; ++mi) acc[mi] = (f32x4){0.f, 0.f, 0.f, 0.f};
      const LAS bf16_t* ub = UL + bt * UBT + (I0 + r + 15) * UBLK + 8 * h;
      const int x0 = 8 * h - r + GROFF - 112;
      const unsigned sh = (unsigned)(x0 & 1) * 16u;
      const LAS unsigned* gq = G32 + (x0 >> 1) - 64 * (I0 + 15);
      const LAS bf16_t* uq = ub - (I0 + 15) * UBLK;
      bf16x8 R[16];
#pragma unroll
      for (int mm = 0; mm < 6; ++mm) R[(mm - 7) & 15] = toep_frag2(gq + 8 * mm, sh);
#define HY_STEP(PAR) { \
          _Pragma("unroll") for (int mm = 6; mm < 14; ++mm) R[(mm - 7 + 8 * (PAR)) & 15] = toep_frag2(gq + 8 * mm, sh); \
          _Pragma("unroll") for (int ks = 0; ks < 4; ++ks) { const bf16x8 B = *(const LAS bf16x8*)(uq + 32 * ks); \
              _Pragma("unroll") for (int mi = 0; mi < 8; ++mi) acc[mi] = __builtin_amdgcn_mfma_f32_16x16x32_bf16(R[(2 * ks - mi + 8 * (PAR)) & 15], B, acc[mi], 0, 0, 0); } \
          gq += 64; uq += UBLK; }
      for (int sp = 0; sp < 40; ++sp) { HY_STEP(0) HY_STEP(1) }
#undef HY_STEP
      const int I = I0 + r;
#pragma unroll
      for (int mi = 0; mi < 8; ++mi) { const int i = 16 * mi + 4 * h; const int f = 128 * I + i;
          const LAS bf16_t* up = UL + bt * UBT + (I + 15) * UBLK + i;
          u32x2 w; w.x = pk2(acc[mi][0] + bias * bf2f(up[0]), acc[mi][1] + bias * bf2f(up[1])); w.y = pk2(acc[mi][2] + bias * bf2f(up[2]), acc[mi][3] + bias * bf2f(up[3]));
          *(u32x2*)(YTg + (size_t)bt * TF + f) = w; }
    }
    if (layer == 0) { f32x4 am[8];
#pragma unroll
      for (int mi = 0; mi < 8; ++mi) am[mi] = (f32x4){0.f, 0.f, 0.f, 0.f};
      const int Lb = -64 + 8 * wave, Le = Lb + 8 + (wave == 7 ? 1 : 0);
      const int x0 = 8 * h - r + GROFF - 112; const unsigned sh = (unsigned)(x0 & 1) * 16u;
      for (int L = Lb; L < Le; ++L) {
          bf16x8 A[14];
          const LAS unsigned* gq = G32 + (x0 >> 1) - 64 * L;
#pragma unroll
          for (int mm = 0; mm < 14; ++mm) A[mm] = toep_frag2(gq + 8 * mm, sh);
#pragma unroll
          for (int ks = 0; ks < 4; ++ks) { const bf16x8 B = *(const LAS bf16x8*)(UL + (r & 1) * UBT + (15 - L) * UBLK + 32 * ks + 8 * h);
#pragma unroll
              for (int mi = 0; mi < 8; ++mi) am[mi] = __builtin_amdgcn_mfma_f32_16x16x32_bf16(A[2 * ks - mi + 7], B, am[mi], 0, 0, 0); }
      }
      if (r < 2) {
#pragma unroll
          for (int mi = 0; mi < 8; ++mi)
#pragma unroll
              for (int q = 0; q < 4; ++q) PART[(wave * 2 + r) * 128 + 16 * mi + 4 * h + q] = am[mi][q]; }
    }
    __syncthreads();
    if (layer == 0 && tid < 32) { const int bt = tid >> 4, i = 112 + (tid & 15); float s = 0.f;
#pragma unroll
        for (int w8 = 0; w8 < 8; ++w8) s += PART[(w8 * 2 + bt) * 128 + i];
        const float uu = bf2f(UL[bt * UBT + 15 * UBLK + i]); YTg[(size_t)bt * TF + i] = (bf16_t)f2bf(s + bias * uu); }
}

__device__ __forceinline__ void gla_decode(int w, int& grp, int& c) { if (w < 512) { grp = w >> 6; c = 1 + (w & 63); } else { grp = w - 512; c = 0; } }

__device__ __forceinline__ unsigned cvt_pk_bf16(float lo, float hi) { return pk2(lo, hi); }
__device__ __forceinline__ bf16x8 pack8(const f32x4 a, const f32x4 b) { u32x4 w; w.x = cvt_pk_bf16(a[0], a[1]); w.y = cvt_pk_bf16(a[2], a[3]); w.z = cvt_pk_bf16(b[0], b[1]); w.w = cvt_pk_bf16(b[2], b[3]); return __builtin_bit_cast(bf16x8, w); }
constexpr int GL_QS = 136, GL_TS = 40;
constexpr int GL_QT = 0, GL_KT = 32 * GL_QS * 2, GL_KHT = 2 * 32 * GL_QS * 2, GL_VT = GL_KHT + 128 * GL_TS * 2, GL_GS = GL_VT + 128 * GL_TS * 2, GL_HEAD = GL_GS + 512;

__device__ __forceinline__ float scan32_add(float v) {
    v += __int_as_float(__builtin_amdgcn_update_dpp(0, __float_as_int(v), 0x111, 0xf, 0xf, false));
    v += __int_as_float(__builtin_amdgcn_update_dpp(0, __float_as_int(v), 0x112, 0xf, 0xf, false));
    v += __int_as_float(__builtin_amdgcn_update_dpp(0, __float_as_int(v), 0x114, 0xf, 0xf, false));
    v += __int_as_float(__builtin_amdgcn_update_dpp(0, __float_as_int(v), 0x118, 0xf, 0xf, false));
    v += __int_as_float(__builtin_amdgcn_update_dpp(0, __float_as_int(v), 0x142, 0xa, 0xf, false));
    return v;
}
template <bool PH3>
__device__ __forceinline__ void gla_item(CParams& p, int layer, int w, LAS unsigned char* lds) {
    int grp, c; gla_decode(w, grp, c);
    const int br = grp >> 2, dir = (grp >> 1) & 1, b = grp & 1, item = grp * NCHK + c;
    const bool incl = !(br == 0 && dir == 1);
    const int tid = opaque_tid(), lane = tid & 63, wave = tid >> 6, hd = wave >> 1, vh = wave & 1, r = lane & 15, h = lane >> 4;
    LAS unsigned char* hb = lds + hd * GL_HEAD;
    const bf16_t* P = (const bf16_t*)(p.ws + R_PMIX);
    const f32x2* RT = (const f32x2*)(p.ws + OFF_ROPE);
    bf16_t* U = (bf16_t*)(p.ws + R_U) + (size_t)item * 65536 + (size_t)(hd * 128 + 4 * h) * 128 + 64 * vh + r;
    f32x4 S[8][4];
#pragma unroll
    for (int dt = 0; dt < 8; ++dt)
#pragma unroll
        for (int vt = 0; vt < 4; ++vt) {
            if (PH3) {
#pragma unroll
                for (int q = 0; q < 4; ++q) S[dt][vt][q] = bf2f(U[(16 * dt + q) * 128 + 16 * vt]);
            } else S[dt][vt] = (f32x4){0.f, 0.f, 0.f, 0.f}; }
    const int fcol = dir ? 5632 : 5120;
    bf16_t* Og = (bf16_t*)(p.ws + R_O) + (size_t)(br * 2 + dir) * MP * W;
    const int nsb = (c == 0) ? 1 : 4;
    for (int sbi = 0; sbi < nsb; ++sbi) {
        const int sb = (c == 0) ? 3 : (dir ? 3 - sbi : sbi);
        __syncthreads();
        {
            const int ip = lane & 31, hw = (lane >> 5) + 2 * wave;
            const int i = sb * 32 + (dir ? 31 - ip : ip), t = c * 128 + i - 112; const bool valid = t >= 0;
            const bf16_t* prow = P + (size_t)row_bci(b, c, i) * NMIX;
#pragma unroll 2
            for (int itc = 0; itc < 4; ++itc) {
                const int d0 = 8 * (hw + 16 * itc), shd = d0 >> 7, sdl = d0 & 127;
                LAS unsigned char* hs = lds + shd * GL_HEAD;
                float q[8], k[8], v[8], l[8];
                if (br == 0) {
                    const u32x4 kr = *(const u32x4*)(prow + 3072 + d0), kp = *(const u32x4*)(prow + 3072 + (d0 ^ 64)), vr = *(const u32x4*)(prow + 3584 + d0);
                    u32x4 qr = (u32x4){0u, 0u, 0u, 0u}, qp = (u32x4){0u, 0u, 0u, 0u};
                    if (PH3) { qr = *(const u32x4*)(prow + 2560 + d0); qp = *(const u32x4*)(prow + 2560 + (d0 ^ 64)); }
                    const f32x4* rt = (const f32x4*)(RT + (size_t)(valid ? t : 0) * 64 + (sdl & 63));
                    const f32x4 c0 = rt[0], c1 = rt[1], c2 = rt[2], c3 = rt[3];
                    const float cs[16] = {c0[0], c0[1], c0[2], c0[3], c1[0], c1[1], c1[2], c1[3], c2[0], c2[1], c2[2], c2[3], c3[0], c3[1], c3[2], c3[3]};
                    const float sgn = (sdl < 64) ? -1.f : 1.f; const float lg = log1pf(-exp2f(-5.0f - (float)shd));
#pragma unroll
                    for (int e = 0; e < 8; ++e) { const unsigned wkr = kr[e >> 1], wkp = kp[e >> 1], wvr = vr[e >> 1], wqr = qr[e >> 1], wqp = qp[e >> 1];
                        const float fkr = (e & 1) ? __uint_as_float(wkr & 0xffff0000u) : __uint_as_float(wkr << 16), fkp = (e & 1) ? __uint_as_float(wkp & 0xffff0000u) : __uint_as_float(wkp << 16);
                        const float fqr = (e & 1) ? __uint_as_float(wqr & 0xffff0000u) : __uint_as_float(wqr << 16), fqp = (e & 1) ? __uint_as_float(wqp & 0xffff0000u) : __uint_as_float(wqp << 16);
                        k[e] = (fkr * cs[2 * e] + sgn * fkp * cs[2 * e + 1]) * 0.08838834764831845f; q[e] = fqr * cs[2 * e] + sgn * fqp * cs[2 * e + 1];
                        v[e] = (e & 1) ? __uint_as_float(wvr & 0xffff0000u) : __uint_as_float(wvr << 16); l[e] = lg; }
                } else {
                    const u32x4 fr = *(const u32x4*)(prow + fcol + d0), vr = *(const u32x4*)(prow + 6144 + d0);
                    u32x4 qr = (u32x4){0u, 0u, 0u, 0u}; if (PH3) qr = *(const u32x4*)(prow + 4608 + d0);
                    const f32x4 la = *(const f32x4*)((const float*)(p.ws + OFF_LBT) + d0), lb4 = *(const f32x4*)((const float*)(p.ws + OFF_LBT) + d0 + 4);
#pragma unroll
                    for (int e = 0; e < 8; ++e) { const unsigned wfr = fr[e >> 1], wvr = vr[e >> 1], wqr = qr[e >> 1];
                        const float ffr = (e & 1) ? __uint_as_float(wfr & 0xffff0000u) : __uint_as_float(wfr << 16), fqr = (e & 1) ? __uint_as_float(wqr & 0xffff0000u) : __uint_as_float(wqr << 16);
                        const float lbv = e < 4 ? la[e & 3] : lb4[e & 3];
                        const float f = lbv + (1.0f - lbv) * sigm(ffr); l[e] = __logf(f); k[e] = 1.0f - f; q[e] = fqr * sigm(fqr);
                        v[e] = (e & 1) ? __uint_as_float(wvr & 0xffff0000u) : __uint_as_float(wvr << 16); }
                }
                if (!valid) {
#pragma unroll
                    for (int e = 0; e < 8; ++e) { q[e] = 0.f; k[e] = 0.f; v[e] = 0.f; l[e] = 0.f; } }
                float eb[8], enb[8];
                if (br == 0) {
                    const float l0 = scan32_add(l[0]); const float a0 = __expf(l0), b0 = __expf(fminf(-l0, 80.0f));
#pragma unroll
                    for (int e = 0; e < 8; ++e) { l[e] = l0; eb[e] = a0; enb[e] = b0; }
                } else {
#pragma unroll
                    for (int e = 0; e < 8; ++e) { l[e] = scan32_add(l[e]); enb[e] = __expf(fminf(-l[e], 80.0f)); eb[e] = PH3 ? __expf(l[e]) : 0.f; }
                }
                float kt[8];
#pragma unroll
                for (int e = 0; e < 8; ++e) kt[e] = k[e] * enb[e];
                LAS bf16_t* sKHT = (LAS bf16_t*)(hs + GL_KHT); LAS bf16_t* sVT = (LAS bf16_t*)(hs + GL_VT);
                if (PH3) { u32x4 wq, wk;
                    wq.x = cvt_pk_bf16(q[0] * eb[0], q[1] * eb[1]); wq.y = cvt_pk_bf16(q[2] * eb[2], q[3] * eb[3]);
                    wq.z = cvt_pk_bf16(q[4] * eb[4], q[5] * eb[5]); wq.w = cvt_pk_bf16(q[6] * eb[6], q[7] * eb[7]);
                    wk.x = cvt_pk_bf16(kt[0], kt[1]); wk.y = cvt_pk_bf16(kt[2], kt[3]); wk.z = cvt_pk_bf16(kt[4], kt[5]); wk.w = cvt_pk_bf16(kt[6], kt[7]);
                    *(LAS u32x4*)((LAS bf16_t*)(hs + GL_QT) + ip * GL_QS + sdl) = wq; *(LAS u32x4*)((LAS bf16_t*)(hs + GL_KT) + ip * GL_QS + sdl) = wk; }
#pragma unroll
                for (int e = 0; e < 8; ++e) { sKHT[(sdl + e) * GL_TS + ip] = (bf16_t)f2bf(kt[e]); sVT[(sdl + e) * GL_TS + ip] = (bf16_t)f2bf(v[e]); }
                if (ip == 31) { LAS float* sGS = (LAS float*)(hs + GL_GS); LAS float* LT = (LAS float*)(lds + 4 * GL_HEAD);
#pragma unroll
                    for (int e = 0; e < 8; ++e) { sGS[sdl + e] = __expf(l[e]); LT[d0 + e] = (sbi == 0 ? 0.f : LT[d0 + e]) + l[e]; } }
            }
        }
        __syncthreads();
        const LAS bf16_t* QT = (const LAS bf16_t*)(hb + GL_QT); const LAS bf16_t* KT = (const LAS bf16_t*)(hb + GL_KT);
        const LAS bf16_t* KHT = (const LAS bf16_t*)(hb + GL_KHT); const LAS bf16_t* VT = (const LAS bf16_t*)(hb + GL_VT); const LAS float* GS = (const LAS float*)(hb + GL_GS);
        if (PH3) {
            f32x4 X[2][2];
#pragma unroll
            for (int a = 0; a < 2; ++a)
#pragma unroll
                for (int bq = 0; bq < 2; ++bq) X[a][bq] = (f32x4){0.f, 0.f, 0.f, 0.f};
#pragma unroll
            for (int kk = 0; kk < 4; ++kk) { bf16x8 aK[2], bQ[2];
#pragma unroll
                for (int t2 = 0; t2 < 2; ++t2) { aK[t2] = *(const LAS bf16x8*)(KT + (16 * t2 + r) * GL_QS + 32 * kk + 8 * h); bQ[t2] = *(const LAS bf16x8*)(QT + (16 * t2 + r) * GL_QS + 32 * kk + 8 * h); }
#pragma unroll
                for (int jt = 0; jt < 2; ++jt)
#pragma unroll
                    for (int it = 0; it < 2; ++it) X[jt][it] = __builtin_amdgcn_mfma_f32_16x16x32_bf16(aK[jt], bQ[it], X[jt][it], 0, 0, 0); }
            bf16x8 PA[2];
#pragma unroll
            for (int it = 0; it < 2; ++it) { f32x4 lo, hi; const int ipx = 16 * it + r;
#pragma unroll
                for (int q = 0; q < 4; ++q) { const int j0 = 4 * h + q, j1 = 16 + 4 * h + q;
                    lo[q] = (incl ? (j0 <= ipx) : (j0 < ipx)) ? X[0][it][q] : 0.f; hi[q] = (incl ? (j1 <= ipx) : (j1 < ipx)) ? X[1][it][q] : 0.f; }
                PA[it] = pack8(lo, hi); }
            f32x4 O[2][4];
#pragma unroll
            for (int vt = 0; vt < 4; ++vt) { const LAS bf16_t* vp = VT + (64 * vh + 16 * vt + r) * GL_TS;
                const u32x2 lo = *(const LAS u32x2*)(vp + 4 * h), hi = *(const LAS u32x2*)(vp + 16 + 4 * h);
                const bf16x8 BV = __builtin_bit_cast(bf16x8, ((u32x4){lo.x, lo.y, hi.x, hi.y}));
#pragma unroll
                for (int it = 0; it < 2; ++it) O[it][vt] = __builtin_amdgcn_mfma_f32_16x16x32_bf16(PA[it], BV, (f32x4){0.f, 0.f, 0.f, 0.f}, 0, 0, 0); }
#pragma unroll
            for (int kk = 0; kk < 4; ++kk) { bf16x8 aQ[2];
#pragma unroll
                for (int it = 0; it < 2; ++it) { const LAS bf16_t* qp = QT + (16 * it + r) * GL_QS + 32 * kk;
                    const u32x2 lo = *(const LAS u32x2*)(qp + 4 * h), hi = *(const LAS u32x2*)(qp + 16 + 4 * h);
                    aQ[it] = __builtin_bit_cast(bf16x8, ((u32x4){lo.x, lo.y, hi.x, hi.y})); }
#pragma unroll
                for (int vt = 0; vt < 4; ++vt) { const bf16x8 BS = pack8(S[2 * kk][vt], S[2 * kk + 1][vt]);
#pragma unroll
                    for (int it = 0; it < 2; ++it) O[it][vt] = __builtin_amdgcn_mfma_f32_16x16x32_bf16(aQ[it], BS, O[it][vt], 0, 0, 0); } }
#pragma unroll
            for (int it = 0; it < 2; ++it)
#pragma unroll
                for (int q = 0; q < 4; ++q) { const int ipx = 16 * it + 4 * h + q, i = sb * 32 + (dir ? 31 - ipx : ipx);
                    if ((c * 128 + i - 112) >= 0) { bf16_t* op = Og + (size_t)row_bci(b, c, i) * W + hd * 128 + 64 * vh + r;
#pragma unroll
                        for (int vt = 0; vt < 4; ++vt) op[16 * vt] = (bf16_t)f2bf(O[it][vt][q]); } }
        }
        {
            bf16x8 bV[4];
#pragma unroll
            for (int vt = 0; vt < 4; ++vt) bV[vt] = *(const LAS bf16x8*)(VT + (64 * vh + 16 * vt + r) * GL_TS + 8 * h);
#pragma unroll
            for (int dt = 0; dt < 8; ++dt) { const f32x4 g4 = *(const LAS f32x4*)(GS + 16 * dt + 4 * h); const bf16x8 aKH = *(const LAS bf16x8*)(KHT + (16 * dt + r) * GL_TS + 8 * h);
#pragma unroll
                for (int vt = 0; vt < 4; ++vt) S[dt][vt] = __builtin_amdgcn_mfma_f32_16x16x32_bf16(aKH, bV[vt], S[dt][vt], 0, 0, 0) * g4; }
        }
    }
    if (!PH3) {
#pragma unroll
        for (int dt = 0; dt < 8; ++dt)
#pragma unroll
            for (int vt = 0; vt < 4; ++vt)
#pragma unroll
                for (int q = 0; q < 4; ++q) U[(16 * dt + q) * 128 + 16 * vt] = (bf16_t)f2bf(S[dt][vt][q]);
        __syncthreads();
        ((float*)(p.ws + R_GG))[(size_t)item * 512 + tid] = __expf(((const LAS float*)(lds + 4 * GL_HEAD))[tid]);
    }
}

__device__ __forceinline__ void gla_carry(CParams& p) {
    const int gidx = blockIdx.x * 512 + opaque_tid();
    if (gidx >= 8 * 16384) return;
    const int grp = gidx >> 14, e4 = gidx & 16383, dir = (grp >> 1) & 1, hdd = (e4 * 4) >> 7;
    bf16_t* U = (bf16_t*)(p.ws + R_U) + (size_t)grp * NCHK * 65536 + e4 * 4; const float* GG = (const float*)(p.ws + R_GG) + (size_t)grp * NCHK * 512 + hdd;
    f32x4 S = (f32x4){0.f, 0.f, 0.f, 0.f};
    for (int s0 = 0; s0 < NCHK; s0 += 5) {
        u32x2 u[5]; float g[5];
#pragma unroll
        for (int q = 0; q < 5; ++q) { const int c = dir ? NCHK - 1 - (s0 + q) : (s0 + q); u[q] = *(const u32x2*)(U + (size_t)c * 65536); g[q] = GG[(size_t)c * 512]; }
#pragma unroll
        for (int q = 0; q < 5; ++q) { const int c = dir ? NCHK - 1 - (s0 + q) : (s0 + q);
            u32x2 w; w.x = pk2(S[0], S[1]); w.y = pk2(S[2], S[3]); *(u32x2*)(U + (size_t)c * 65536) = w;
            const f32x4 uv = (f32x4){__uint_as_float(u[q].x << 16), __uint_as_float(u[q].x & 0xffff0000u), __uint_as_float(u[q].y << 16), __uint_as_float(u[q].y & 0xffff0000u)};
            S = S * g[q] + uv; }
    }
}

__device__ __forceinline__ float row16_sum(float v) {
    v += __int_as_float(__builtin_amdgcn_update_dpp(0, __float_as_int(v), 0x121, 0xf, 0xf, false));
    v += __int_as_float(__builtin_amdgcn_update_dpp(0, __float_as_int(v), 0x122, 0xf, 0xf, false));
    v += __int_as_float(__builtin_amdgcn_update_dpp(0, __float_as_int(v), 0x124, 0xf, 0xf, false));
    v += __int_as_float(__builtin_amdgcn_update_dpp(0, __float_as_int(v), 0x128, 0xf, 0xf, false));
    return v;
}
__device__ __forceinline__ void gla_s4(CParams& p) {
    const int tid0 = opaque_tid(); const int lane = tid0 & 63, gw = blockIdx.x * 8 + (tid0 >> 6), NW = gridDim.x * 8;
    const bf16_t* P = (const bf16_t*)(p.ws + R_PMIX); const bf16_t* O = (const bf16_t*)(p.ws + R_O); bf16_t* Z = (bf16_t*)(p.ws + OFF_Z);
    for (int it = gw; it < MP * 2; it += NW) { const int row = it >> 1, br = it & 1;
        bf16_t* zp = Z + (size_t)row * D + 1024 + br * W + lane * 8;
        if (row >= MX && ((row - MX) & 127) < 112) { *(u32x4*)zp = (u32x4){0u, 0u, 0u, 0u}; continue; }
        const u32x4 of = *(const u32x4*)(O + ((size_t)(br * 2 + 0) * MP + row) * W + lane * 8), ob = *(const u32x4*)(O + ((size_t)(br * 2 + 1) * MP + row) * W + lane * 8);
        const u32x4 gv = *(const u32x4*)(P + (size_t)row * NMIX + (br ? 6656 : 4096) + lane * 8);
        float o[8], g[8];
#pragma unroll
        for (int q = 0; q < 4; ++q) { o[2 * q] = __uint_as_float(of[q] << 16) + __uint_as_float(ob[q] << 16); o[2 * q + 1] = __uint_as_float(of[q] & 0xffff0000u) + __uint_as_float(ob[q] & 0xffff0000u);
            g[2 * q] = __uint_as_float(gv[q] << 16); g[2 * q + 1] = __uint_as_float(gv[q] & 0xffff0000u); }
        float s = 0.f;
#pragma unroll
        for (int q = 0; q < 8; ++q) s += o[q];
        s = row16_sum(s);
        const float mu = br ? 0.f : s * (1.0f / 128.0f);
        float s2 = 0.f;
#pragma unroll
        for (int q = 0; q < 8; ++q) { o[q] -= mu; s2 += o[q] * o[q]; }
        s2 = row16_sum(s2);
        const float rs = __builtin_amdgcn_rsqf(s2 * (1.0f / 128.0f) + EPS);
        u32x4 w;
#pragma unroll
        for (int q = 0; q < 4; ++q) w[q] = pk2(o[2 * q] * rs * siluf(g[2 * q]), o[2 * q + 1] * rs * siluf(g[2 * q + 1]));
        *(u32x4*)zp = w; }
}


__device__ __forceinline__ void skinny_acc(const bf16_t* A, int lda, const bf16_t* Wrow, int ldw, int k_begin, int nk, int r, int h, f32x4 (&acc)[2]) {
    const bf16_t* a0 = A + (size_t)(MX + 112 + r) * lda + 8 * h + k_begin;
    const bf16_t* a1 = A + (size_t)(MX + 128 + 112 + r) * lda + 8 * h + k_begin;
    const bf16_t* bp = Wrow + (size_t)r * ldw + 8 * h + k_begin;
#pragma unroll 8
    for (int ks = 0; ks < nk; ++ks) { const bf16x8 x0 = *(const bf16x8*)(a0 + 32 * ks), x1 = *(const bf16x8*)(a1 + 32 * ks), bb = *(const bf16x8*)(bp + 32 * ks);
        acc[0] = __builtin_amdgcn_mfma_f32_16x16x32_bf16(x0, bb, acc[0], 0, 0, 0); acc[1] = __builtin_amdgcn_mfma_f32_16x16x32_bf16(x1, bb, acc[1], 0, 0, 0); }
}
#define SK_HEAD const int tid = opaque_tid(), lane = tid & 63, wave = tid >> 6, r = lane & 15, h = lane >> 4; LAS float* part = (LAS float*)lds; \
    const int e_mt = tid >> 8, e_q = (tid >> 6) & 3, e_h = (tid & 63) >> 4, e_r = tid & 15; const size_t e_row = (size_t)(MX + 128 * e_mt + 112 + 4 * e_h + e_q);
__device__ __forceinline__ void sk_put(LAS float* part, int wave, int lane, const f32x4 (&acc)[2]) {
#pragma unroll
    for (int mt = 0; mt < 2; ++mt)
#pragma unroll
        for (int q = 0; q < 4; ++q) part[wave * 512 + (mt * 4 + q) * 64 + lane] = acc[mt][q];
}
__device__ __forceinline__ float sk_sum8(const LAS float* part, int tid) { float s = 0.f;
#pragma unroll
    for (int w8 = 0; w8 < 8; ++w8) s += part[w8 * 512 + tid];
    return s; }
__device__ __forceinline__ void skinny_in(CParams& p, int mode, LAS unsigned char* lds) {
    SK_HEAD
    const bf16_t* NB = (const bf16_t*)(p.ws + OFF_NB); const bf16_t* WIN = (const bf16_t*)(p.ws + OFF_WIN) + (size_t)(mode ? NMIX : 0) * D;
    const int ntile = mode ? NGATE / 16 : NMIX / 16;
    for (int t0 = blockIdx.x; t0 < ntile; t0 += 2 * gridDim.x) { const int t1 = t0 + gridDim.x; const bool two = t1 < ntile; const int t1c = two ? t1 : t0;
        f32x4 aA[2] = {(f32x4){0.f, 0.f, 0.f, 0.f}, (f32x4){0.f, 0.f, 0.f, 0.f}}, aB[2] = {(f32x4){0.f, 0.f, 0.f, 0.f}, (f32x4){0.f, 0.f, 0.f, 0.f}};
        __syncthreads();
        { const int kb = wave * (D / 8);
          const bf16_t* a0 = NB + (size_t)(MX + 112 + r) * D + 8 * h + kb; const bf16_t* a1 = NB + (size_t)(MX + 128 + 112 + r) * D + 8 * h + kb;
          const bf16_t* b0 = WIN + (size_t)(t0 * 16 + r) * D + 8 * h + kb; const bf16_t* b1 = WIN + (size_t)(t1c * 16 + r) * D + 8 * h + kb;
#pragma unroll
          for (int ks = 0; ks < D / 256; ++ks) { const bf16x8 x0 = *(const bf16x8*)(a0 + 32 * ks), x1 = *(const bf16x8*)(a1 + 32 * ks), w0 = *(const bf16x8*)(b0 + 32 * ks), w1 = *(const bf16x8*)(b1 + 32 * ks);
              aA[0] = __builtin_amdgcn_mfma_f32_16x16x32_bf16(x0, w0, aA[0], 0, 0, 0); aA[1] = __builtin_amdgcn_mfma_f32_16x16x32_bf16(x1, w0, aA[1], 0, 0, 0);
              aB[0] = __builtin_amdgcn_mfma_f32_16x16x32_bf16(x0, w1, aB[0], 0, 0, 0); aB[1] = __builtin_amdgcn_mfma_f32_16x16x32_bf16(x1, w1, aB[1], 0, 0, 0); } }
        sk_put(part, wave, lane, aA); sk_put(part + 4096, wave, lane, aB);
        __syncthreads();
        const float sA = sk_sum8(part, tid), sB = sk_sum8(part + 4096, tid);
        if (mode) { bf16_t* G = (bf16_t*)(p.ws + R_G); G[e_row * NGATE + t0 * 16 + e_r] = (bf16_t)f2bf(sA); if (two) G[e_row * NGATE + t1 * 16 + e_r] = (bf16_t)f2bf(sB); }
        else { bf16_t* P = (bf16_t*)(p.ws + R_PMIX); P[e_row * NMIX + t0 * 16 + e_r] = (bf16_t)f2bf(sA); if (two) P[e_row * NMIX + t1 * 16 + e_r] = (bf16_t)f2bf(sB); } }
}
__device__ __forceinline__ void skinny_branch(CParams& p, LAS unsigned char* lds) {
    SK_HEAD
    const bf16_t* Z = (const bf16_t*)(p.ws + OFF_Z); const bf16_t* WBO = (const bf16_t*)(p.ws + OFF_WBO); const bf16_t* G = (const bf16_t*)(p.ws + R_G); bf16_t* MB = (bf16_t*)(p.ws + R_MB);
    const int z = wave >> 1, kh = wave & 1;
    for (int tile = blockIdx.x; tile < D / 16; tile += gridDim.x) { f32x4 acc[2] = {(f32x4){0.f, 0.f, 0.f, 0.f}, (f32x4){0.f, 0.f, 0.f, 0.f}};
        __syncthreads();
        skinny_acc(Z + z * W, D, WBO + (size_t)z * D * W + (size_t)tile * 16 * W, W, kh * (W / 2), W / 64, r, h, acc);
        sk_put(part, wave, lane, acc);
        __syncthreads();
        float tot = 0.f;
#pragma unroll
        for (int zz = 0; zz < 4; ++zz) tot += sigm(bf2f(G[e_row * NGATE + zz * D + tile * 16 + e_r])) * (part[(2 * zz) * 512 + tid] + part[(2 * zz + 1) * 512 + tid]);
        MB[e_row * D + tile * 16 + e_r] = (bf16_t)f2bf(tot); }
}
__device__ __forceinline__ void skinny_resid(CParams& p, const bf16_t* A, int lda, const bf16_t* Wt, int K, LAS unsigned char* lds) {
    SK_HEAD
    float* H = (float*)(p.ws + OFF_H);
    for (int tile = blockIdx.x; tile < D / 16; tile += gridDim.x) { f32x4 acc[2] = {(f32x4){0.f, 0.f, 0.f, 0.f}, (f32x4){0.f, 0.f, 0.f, 0.f}};
        __syncthreads();
        skinny_acc(A, lda, Wt + (size_t)tile * 16 * K, K, wave * (K / 8), K / 256, r, h, acc);
        sk_put(part, wave, lane, acc);
        __syncthreads();
        H[e_row * D + tile * 16 + e_r] += sk_sum8(part, tid); }
}
__device__ __forceinline__ void skinny_swiglu(CParams& p, LAS unsigned char* lds) {
    SK_HEAD
    const bf16_t* NB = (const bf16_t*)(p.ws + OFF_NB); const bf16_t* WGU = (const bf16_t*)(p.ws + OFF_WGU); bf16_t* FF = (bf16_t*)(p.ws + R_FF);
    for (int tile = blockIdx.x; tile < DFF / 16; tile += gridDim.x) { const int c0 = tile * 16, wr0 = 256 * (c0 >> 7) + (c0 & 127);
        f32x4 ag[2] = {(f32x4){0.f, 0.f, 0.f, 0.f}, (f32x4){0.f, 0.f, 0.f, 0.f}}, au[2] = {(f32x4){0.f, 0.f, 0.f, 0.f}, (f32x4){0.f, 0.f, 0.f, 0.f}};
        __syncthreads();
        { const int kb = wave * (D / 8);
          const bf16_t* a0 = NB + (size_t)(MX + 112 + r) * D + 8 * h + kb; const bf16_t* a1 = NB + (size_t)(MX + 128 + 112 + r) * D + 8 * h + kb;
          const bf16_t* bg = WGU + (size_t)(wr0 + r) * D + 8 * h + kb; const bf16_t* bu = WGU + (size_t)(wr0 + 128 + r) * D + 8 * h + kb;
#pragma unroll
          for (int ks = 0; ks < D / 256; ++ks) { const bf16x8 x0 = *(const bf16x8*)(a0 + 32 * ks), x1 = *(const bf16x8*)(a1 + 32 * ks), wg = *(const bf16x8*)(bg + 32 * ks), wu = *(const bf16x8*)(bu + 32 * ks);
              ag[0] = __builtin_amdgcn_mfma_f32_16x16x32_bf16(x0, wg, ag[0], 0, 0, 0); ag[1] = __builtin_amdgcn_mfma_f32_16x16x32_bf16(x1, wg, ag[1], 0, 0, 0);
              au[0] = __builtin_amdgcn_mfma_f32_16x16x32_bf16(x0, wu, au[0], 0, 0, 0); au[1] = __builtin_amdgcn_mfma_f32_16x16x32_bf16(x1, wu, au[1], 0, 0, 0); } }
        sk_put(part, wave, lane, ag); sk_put(part + 4096, wave, lane, au);
        __syncthreads();
        const float g = sk_sum8(part, tid), u = sk_sum8(part + 4096, tid);
        FF[e_row * DFF + c0 + e_r] = (bf16_t)f2bf(siluf(g) * u); }
}


#define XB_TMO      128
#define XB_XCNT(j)  (256  + 64 * (j))
#define XB_XSUB(j)  (1280 + 64 * (j))
#define XB_XGEN(j)  (2304 + 64 * (j))
#define XB_TOP      3328
#define XB_TOPGEN   3392
#define XCD_BAR_WORDS 3456
#define XB_SPIN_CAP (1u << 22)
__device__ __forceinline__ unsigned xb_ld(unsigned* p)              { return __hip_atomic_load(p, __ATOMIC_RELAXED, __HIP_MEMORY_SCOPE_AGENT); }
__device__ __forceinline__ unsigned xb_add(unsigned* p, unsigned v) { return __hip_atomic_fetch_add(p, v, __ATOMIC_RELAXED, __HIP_MEMORY_SCOPE_AGENT); }
__device__ __forceinline__ unsigned xb_xcc_id() { return (unsigned)__builtin_amdgcn_s_getreg((3 << 11) | 20) & 0xFu; }
#define XB_SPIN(cond, bar) do { unsigned _sp = 0; while (cond) { __builtin_amdgcn_s_sleep(1); \
    if ((++_sp & 255u) == 0u) { if (xb_ld(&(bar)[XB_TMO])) break; if (_sp > XB_SPIN_CAP) { atomicAdd(&(bar)[XB_TMO], 1u); break; } } } } while (0)
struct XcdBarrier { unsigned* bar; unsigned x; volatile LAS unsigned* st; };
__device__ __forceinline__ XcdBarrier xcd_barrier_post(unsigned* bar, volatile LAS unsigned* st) {
    XcdBarrier b; b.bar = bar; b.x = xb_xcc_id(); b.st = st;
    if (threadIdx.x == 0) (void)xb_add(&bar[XB_XCNT(b.x)], 1u);
    return b;
}
__device__ __forceinline__ void xcd_barrier_complete(unsigned* bar, unsigned x, unsigned& nloc, unsigned& nx) {
    const unsigned G = gridDim.x * gridDim.y * gridDim.z;
    unsigned sum, cnt, mine, sp = 0u;
    for (;;) {
        sum = 0u; cnt = 0u; mine = 0u;
#pragma unroll
        for (unsigned j = 0; j < 16; ++j) { const unsigned c = xb_ld(&bar[XB_XCNT(j)]); sum += c; cnt += (c > 0u) ? 1u : 0u; mine = (j == x) ? c : mine; }
        if (sum == G) break;
        __builtin_amdgcn_s_sleep(1);
        if ((++sp & 255u) == 0u) { if (xb_ld(&bar[XB_TMO])) break; if (sp > XB_SPIN_CAP) { atomicAdd(&bar[XB_TMO], 1u); break; } }
    }
    nloc = mine > 0u ? mine : 1u; nx = cnt > 0u ? cnt : 1u;
}
__device__ __forceinline__ void xcd_barrier(const XcdBarrier& b) {
    asm volatile("s_waitcnt vmcnt(0)" ::: "memory");
    __syncthreads();
    if (threadIdx.x == 0) {
        unsigned* bar = b.bar;
        __builtin_amdgcn_s_waitcnt(0);
        unsigned nloc = b.st[0], nx = b.st[1];
        if (nloc == 0u) { xcd_barrier_complete(bar, b.x, nloc, nx); b.st[0] = nloc; b.st[1] = nx; }
        const unsigned old = xb_add(&bar[XB_XSUB(b.x)], 1u);
        const unsigned gen = old / nloc;
        if (old + 1u == (gen + 1u) * nloc) {
            __builtin_amdgcn_fence(__ATOMIC_RELEASE, "agent");
            asm volatile("s_waitcnt vmcnt(0)" ::: "memory");
            const unsigned og = xb_add(&bar[XB_TOP], 1u);
            const unsigned tg = og / nx;
            if (og + 1u == (tg + 1u) * nx) xb_add(&bar[XB_TOPGEN], 1u);
            else XB_SPIN(xb_ld(&bar[XB_TOPGEN]) == tg, bar);
            __builtin_amdgcn_fence(__ATOMIC_ACQUIRE, "agent");
            xb_add(&bar[XB_XGEN(b.x)], 1u);
            asm volatile("s_waitcnt vmcnt(0)" ::: "memory");
        } else {
            XB_SPIN(xb_ld(&bar[XB_XGEN(b.x)]) == gen, bar);
            __builtin_amdgcn_fence(__ATOMIC_ACQUIRE, "agent");
            asm volatile("s_waitcnt vmcnt(0)" ::: "memory");
        }
    }
    __syncthreads();
}

#ifndef WG_A
#define WG_A 4
#endif
#ifndef WG_N8
#define WG_N8 4
#endif
#ifndef PH_MASK
#define PH_MASK 0xFFFFFFF
#endif
#ifndef REP_MASK
#define REP_MASK 0
#endif
#define PH(n) for (int _r = 0, _n = 1 + ((p.rep >> (n)) & 1); _r < _n; ++_r) if (PH_MASK & (1 << (n)))
__device__ __forceinline__ CParams* kparams() { CParams* q = (CParams*)__builtin_amdgcn_kernarg_segment_ptr(); asm volatile("" : "+s"(q)); return q; }
#define p (*kparams())
__global__ void __launch_bounds__(512, 2) mega(Params p_unused) {
    extern __shared__ __attribute__((aligned(16))) unsigned char lds_raw[];
    LAS unsigned char* lds = (LAS unsigned char*)lds_raw;
    cg::grid_group grid = cg::this_grid();
    const int G = gridDim.x, bx = blockIdx.x;
    volatile LAS unsigned* xst = (volatile LAS unsigned*)(lds + 157680);
    if (threadIdx.x == 0) { xst[0] = 0u; xst[1] = 0u; }
    __syncthreads();
    const XcdBarrier xb = xcd_barrier_post((unsigned*)(p.ws + OFF_BAR), xst);
#pragma unroll 1
    for (int layer = 0; layer < 2; ++layer) {
        PH(0) phase_prep(p, layer, lds);
        if (layer == 0) grid.sync(); else xcd_barrier(xb);
        PH(1) { pg8::PlainSched S{MX / 256, NMIX / 256, G, bx, (const char*)(p.ws + OFF_NB), (const char*)(p.ws + OFF_WIN), (size_t)256 * D * 2, (size_t)256 * D * 2, WG_A};
          pg8::EpiBf16<0> E{(bf16_t*)(p.ws + R_PMIX), NMIX};
          pg8::gemm_phase(lds, D, D, D, S, E); }
        PH(18) skinny_in(p, 0, lds);
        xcd_barrier(xb);
        PH(2) for (int it = bx; it < 520; it += G) gla_item<false>(p, layer, it, lds);
        PH(3) for (int it = (G == 256 ? (bx ^ 128) : bx); it < 1040; it += G) lru_s1_item(p, layer, it, lds);
        PH(4) for (int it = (G == 256 ? (bx ^ 64) : bx); it < 1040; it += G) hy_s1_item(p, layer, it);
        xcd_barrier(xb);
        PH(5) for (int ch = bx; ch < W; ch += G) hy_conv_item(p, layer, ch, lds);
        PH(6) lru_carry(p);
        PH(6) gla_carry(p);
        xcd_barrier(xb);
        PH(7) for (int it = bx; it < 520; it += G) gla_item<true>(p, layer, it, lds);
        PH(8) for (int it = (G == 256 ? (bx ^ 128) : bx); it < 1040; it += G) lru_s3_item(p, it, lds);
        PH(9) for (int it = (G == 256 ? (bx ^ 64) : bx); it < 1040; it += G) hy_s3_item(p, layer, it);
        xcd_barrier(xb);
        PH(10) gla_s4(p);
        __syncthreads();
        PH(11) { pg8::PlainSched S{MX / 256, NGATE / 256, G, bx, (const char*)(p.ws + OFF_NB), (const char*)(p.ws + OFF_WIN) + (size_t)NMIX * D * 2, (size_t)256 * D * 2, (size_t)256 * D * 2, WG_A};
          pg8::EpiBf16<0> E{(bf16_t*)(p.ws + R_G), NGATE};
          pg8::gemm_phase(lds, D, D, D, S, E); }
        if (layer == 0) { PH(19) skinny_in(p, 1, lds); }
        xcd_barrier(xb);
        PH(12) { pg8::BranchSched S{MX / 256, D / 256, G, bx, (const char*)(p.ws + OFF_Z), (const char*)(p.ws + OFF_WBO), (size_t)256 * D * 2, (size_t)256 * W * 2, WG_N8};
          pg8::EpiBranch E{(bf16_t*)(p.ws + R_MB), (const bf16_t*)(p.ws + R_G)};
          pg8::gemm_phase(lds, D, W, W, S, E); }
        if (layer == 0) { PH(20) skinny_branch(p, lds); }
        xcd_barrier(xb);
        PH(13) { pg8::PlainSched S{MX / 256, D / 256, G, bx, (const char*)(p.ws + R_MB), (const char*)(p.ws + OFF_WOUT), (size_t)256 * D * 2, (size_t)256 * D * 2, WG_N8};
          pg8::EpiResid E{(float*)(p.ws + OFF_H), layer == 0 ? p.in[0] : (const float*)(p.ws + OFF_H)};
          pg8::gemm_phase(lds, D, D, D, S, E); }
        if (layer == 0) { PH(21) skinny_resid(p, (const bf16_t*)(p.ws + R_MB), D, (const bf16_t*)(p.ws + OFF_WOUT), D, lds); }
        xcd_barrier(xb);
        PH(14) norm_rows(p, 1, p.in[3] + layer * D, layer == 0 ? MP : MX);
        xcd_barrier(xb);
        PH(15) { pg8::PlainSched S{MX / 256, 2 * DFF / 256, G, bx, (const char*)(p.ws + OFF_NB), (const char*)(p.ws + OFF_WGU), (size_t)256 * D * 2, (size_t)256 * D * 2, 16};
          pg8::EpiSwiglu E{(bf16_t*)(p.ws + R_FF)};
          pg8::gemm_phase(lds, D, D, D, S, E); }
        if (layer == 0) { PH(22) skinny_swiglu(p, lds); }
        xcd_barrier(xb);
        PH(16) { pg8::PlainSched S{MX / 256, D / 256, G, bx, (const char*)(p.ws + R_FF), (const char*)(p.ws + OFF_WD), (size_t)256 * DFF * 2, (size_t)256 * DFF * 2, WG_N8};
          pg8::EpiResid E{(float*)(p.ws + OFF_H), (const float*)(p.ws + OFF_H)};
          pg8::gemm_phase(lds, DFF, DFF, DFF, S, E); }
        if (layer == 0) { PH(23) skinny_resid(p, (const bf16_t*)(p.ws + R_FF), DFF, (const bf16_t*)(p.ws + OFF_WD), DFF, lds); }
        xcd_barrier(xb);
    }
    PH(17) norm_rows(p, 3, p.in[27], MX);
}

#undef p
extern "C" void kernel_launch(void* const* d_in, const int* in_sizes, int n_in, void* d_out, int out_size,
                              void* d_ws, size_t ws_size, hipStream_t stream) {
    constexpr size_t kLds = 157696;
    static int grid_blocks = 0;
    if (!grid_blocks) {
        int dev = 0, cus = 0, per_cu = 0;
        hipGetDevice(&dev);
        hipDeviceGetAttribute(&cus, hipDeviceAttributeMultiprocessorCount, dev);
        hipFuncSetAttribute((const void*)mega, hipFuncAttributeMaxDynamicSharedMemorySize, (int)kLds);
        hipOccupancyMaxActiveBlocksPerMultiprocessor(&per_cu, (const void*)mega, 512, kLds);
        if (per_cu < 1) per_cu = 1;
        grid_blocks = cus * per_cu;
        if (ws_size < WS_TOTAL || n_in != 28) { fprintf(stderr, "kernel_launch: workspace %zu < %zu or n_in %d != 28\n", ws_size, (size_t)WS_NEED, n_in); grid_blocks = -1; }
    }
    if (grid_blocks < 0) return;
    if (hipMemsetAsync((char*)d_ws + OFF_BAR, 0, 16384, stream) != hipSuccess) { fprintf(stderr, "kernel_launch: memset failed\n"); return; }
    Params p{};
    for (int i = 0; i < 28; ++i) p.in[i] = (const float*)d_in[i];
    p.out = (float*)d_out; p.ws = (unsigned char*)d_ws; p.rep = REP_MASK; p.pad = 0;
    void* args[] = {&p};
    hipError_t e = hipLaunchCooperativeKernel((void*)mega, dim3(grid_blocks), dim3(512), args, kLds, stream);
    if (e != hipSuccess) fprintf(stderr, "cooperative launch failed: %s (grid %d)\n", hipGetErrorString(e), grid_blocks);
}
```
